# Optimizing an MI355X kernel written in HIP

```python
import math
import jax, jax.numpy as jnp
from jax import lax
import numpy as np

D_MODEL = 2048
BATCH = 16
SEQ = 2048
DEPTH = 2

RET_HEADS = 8
RET_HEAD_DIM = 128
RET_CHUNK = 128
MLSTM_HEADS = 4
MLSTM_QK_DIM = 128
MLSTM_V_DIM = 256
MLSTM_CHUNK = 128
MLSTM_CONV = 4
MOBA_HEADS = 8
MOBA_HEAD_DIM = 128
MOBA_BLOCK = 256
MOBA_TOPK = 3
MOBA_QCHUNK = 64
REL_BUCKETS = 32
REL_MAX_DIST = 128
D_FF = 4 * D_MODEL
ROPE_BASE = 10000.0
EPS = 1e-6

RET_W = RET_HEADS * RET_HEAD_DIM
MLSTM_QK_W = MLSTM_HEADS * MLSTM_QK_DIM
MLSTM_V_W = MLSTM_HEADS * MLSTM_V_DIM
MOBA_W = MOBA_HEADS * MOBA_HEAD_DIM
N_BRANCH = 3
IN_SPLITS = (RET_W, RET_W, RET_W, RET_W,
             MLSTM_QK_W, MLSTM_QK_W, MLSTM_V_W, MLSTM_V_W, MLSTM_HEADS, MLSTM_HEADS,
             MOBA_W, MOBA_W, MOBA_W,
             N_BRANCH * D_MODEL)
D_IN = sum(IN_SPLITS)

kernel_name = "hybrid_retention_mlstm_moba_gated_block"


def rms_norm(x, w):
    xf = x.astype(jnp.float32)
    y = xf * lax.rsqrt(jnp.mean(xf * xf, axis=-1, keepdims=True) + EPS)
    return (y * w.astype(jnp.float32)).astype(x.dtype)


def head_rms(x):
    return x * lax.rsqrt(jnp.mean(x * x, axis=-1, keepdims=True) + EPS)


def rotary(x, pos):
    half = x.shape[-1] // 2
    inv = ROPE_BASE ** (-jnp.arange(half, dtype=jnp.float32) / half)
    ang = pos.astype(jnp.float32)[:, None] * inv[None, :]
    cos, sin = jnp.cos(ang), jnp.sin(ang)
    x1, x2 = x[..., :half], x[..., half:]
    return jnp.concatenate([x1 * cos - x2 * sin, x1 * sin + x2 * cos], axis=-1)


def causal_dwconv(x, w, b):
    K = w.shape[0]
    S = x.shape[1]
    xp = jnp.pad(x, ((0, 0), (K - 1, 0), (0, 0)))
    y = xp[:, 0:S] * w[0]
    for j in range(1, K):
        y = y + xp[:, j:j + S] * w[j]
    return y + b


def retention(q, k, v, g):
    B, S, H, dh = q.shape
    L = RET_CHUNK
    N = S // L
    pos = jnp.arange(S)
    q = rotary(jnp.swapaxes(q, 1, 2).astype(jnp.float32), pos) * (dh ** -0.5)
    k = rotary(jnp.swapaxes(k, 1, 2).astype(jnp.float32), pos)
    v = jnp.swapaxes(v, 1, 2).astype(jnp.float32)
    q = q.reshape(B, H, N, L, dh)
    k = k.reshape(B, H, N, L, dh)
    v = v.reshape(B, H, N, L, dh)
    log_gamma = jnp.log1p(-jnp.exp2(-5.0 - jnp.arange(H, dtype=jnp.float32)))
    idx = jnp.arange(L, dtype=jnp.float32)
    diff = idx[:, None] - idx[None, :]
    decay = jnp.where(diff >= 0, jnp.exp(jnp.maximum(diff, 0.0) * log_gamma[:, None, None]), 0.0)
    scores = jnp.einsum('bhnld,bhnmd->bhnlm', q, k) * decay[:, None]
    intra = jnp.einsum('bhnlm,bhnme->bhnle', scores, v)
    zeta = jnp.exp((L - 1 - idx)[None, :] * log_gamma[:, None])
    xi = jnp.exp((idx + 1.0)[None, :] * log_gamma[:, None])
    kv = jnp.einsum('bhnld,bhnle->bhnde', k * zeta[:, None, :, None], v)
    gamma_l = jnp.exp(L * log_gamma)

    def step(R, kv_n):
        return R * gamma_l[:, None, None] + kv_n, R

    _, R_prev = lax.scan(step, jnp.zeros((B, H, dh, dh), jnp.float32), jnp.moveaxis(kv, 2, 0))
    R_prev = jnp.moveaxis(R_prev, 0, 2)
    inter = jnp.einsum('bhnld,bhnde->bhnle', q, R_prev) * xi[:, None, :, None]
    o = head_rms((intra + inter).reshape(B, H, S, dh))
    o = jnp.swapaxes(o, 1, 2).reshape(B, S, H * dh)
    return o * jax.nn.silu(g.astype(jnp.float32))


def mlstm(q, k, v, o, i_pre, f_pre, norm_w):
    B, S, H, dk = q.shape
    dv = v.shape[-1]
    L = MLSTM_CHUNK
    N = S // L

    def chunk(t):
        return jnp.swapaxes(t, 1, 2).astype(jnp.float32).reshape((B, H, N, L) + t.shape[3:])

    q = chunk(q) * (dk ** -0.5)
    k = chunk(k)
    v = chunk(v)
    li = chunk(i_pre)
    lf = jax.nn.log_sigmoid(chunk(f_pre))
    bcum = jnp.cumsum(lf, axis=-1)
    gtot = bcum[..., -1]
    causal = jnp.tril(jnp.ones((L, L), dtype=bool))
    dlog = jnp.where(causal, bcum[..., :, None] - bcum[..., None, :] + li[..., None, :], -jnp.inf)
    w_loc = gtot[..., None] - bcum + li
    m_loc = jnp.max(w_loc, axis=-1)
    e_loc = jnp.exp(w_loc - m_loc[..., None])
    C_loc = jnp.einsum('bhnl,bhnld,bhnle->bhnde', e_loc, k, v)
    n_loc = jnp.einsum('bhnl,bhnld->bhnd', e_loc, k)

    def step(carry, xs):
        C, n, m = carry
        Cl, nl, ml, g = xs
        m_new = jnp.maximum(g + m, ml)
        a = jnp.exp(g + m - m_new)
        bb = jnp.exp(ml - m_new)
        C_new = a[..., None, None] * C + bb[..., None, None] * Cl
        n_new = a[..., None] * n + bb[..., None] * nl
        return (C_new, n_new, m_new), (C, n, m)

    init = (jnp.zeros((B, H, dk, dv), jnp.float32), jnp.zeros((B, H, dk), jnp.float32),
            jnp.zeros((B, H), jnp.float32))
    xs = (jnp.moveaxis(C_loc, 2, 0), jnp.moveaxis(n_loc, 2, 0), jnp.moveaxis(m_loc, 2, 0),
          jnp.moveaxis(gtot, 2, 0))
    _, (C_prev, n_prev, m_prev) = lax.scan(step, init, xs)
    C_prev = jnp.moveaxis(C_prev, 0, 2)
    n_prev = jnp.moveaxis(n_prev, 0, 2)
    m_prev = jnp.moveaxis(m_prev, 0, 2)
    inter_log = bcum + m_prev[..., None]
    m_pos = jnp.maximum(inter_log, jnp.max(dlog, axis=-1))
    s_intra = jnp.einsum('bhnld,bhnmd->bhnlm', q, k) * jnp.exp(dlog - m_pos[..., None])
    inter_scale = jnp.exp(inter_log - m_pos)
    num = (jnp.einsum('bhnlm,bhnme->bhnle', s_intra, v)
           + inter_scale[..., None] * jnp.einsum('bhnld,bhnde->bhnle', q, C_prev))
    den = jnp.sum(s_intra, axis=-1) + inter_scale * jnp.einsum('bhnld,bhnd->bhnl', q, n_prev)
    h = num / jnp.maximum(jnp.abs(den), jnp.exp(-m_pos))[..., None]
    h = head_rms(h.reshape(B, H, S, dv))
    h = jnp.swapaxes(h, 1, 2).reshape(B, S, H * dv) * norm_w.astype(jnp.float32)
    return h * jax.nn.sigmoid(o.astype(jnp.float32))


def t5_bucket(dist):
    n = jnp.maximum(dist, 0)
    exact = REL_BUCKETS // 2
    nf = jnp.maximum(n, 1).astype(jnp.float32)
    large = exact + (jnp.log(nf / exact) / math.log(REL_MAX_DIST / exact)
                     * (REL_BUCKETS - exact)).astype(jnp.int32)
    large = jnp.minimum(large, REL_BUCKETS - 1)
    return jnp.where(n < exact, n, large)


def moba(q, k, v, rel_bias):
    B, S, H, dh = q.shape
    BS = MOBA_BLOCK
    QC = MOBA_QCHUNK
    NB = -(-S // BS)
    S_pad = NB * BS
    n_sel = min(MOBA_TOPK, NB - 1)
    nC = S // QC
    q = jnp.swapaxes(q, 1, 2).astype(jnp.float32) * (dh ** -0.5)
    pad = ((0, 0), (0, 0), (0, S_pad - S), (0, 0))
    kb = jnp.pad(jnp.swapaxes(k, 1, 2).astype(jnp.float32), pad).reshape(B, H, NB, BS, dh)
    vb = jnp.pad(jnp.swapaxes(v, 1, 2).astype(jnp.float32), pad).reshape(B, H, NB, BS, dh)
    table_t = rel_bias.T.astype(jnp.float32)
    hid = jnp.arange(H)[None, :, None, None]
    if n_sel > 0:
        kmean = jnp.mean(kb, axis=3)
        gate = jnp.einsum('bhsd,bhnd->bhsn', q, kmean)
        past = jnp.arange(NB)[None, :] < (jnp.arange(S) // BS)[:, None]
        gate = jnp.where(past, gate, -jnp.inf)
        _, sel = lax.top_k(gate, n_sel)
        sel = sel.astype(jnp.int32)
    else:
        sel = jnp.zeros((B, H, S, 0), jnp.int32)
    qc = jnp.moveaxis(q.reshape(B, H, nC, QC, dh), 2, 0)
    selc = jnp.moveaxis(sel.reshape(B, H, nC, QC, n_sel), 2, 0)
    gather = jax.vmap(jax.vmap(lambda blocks, i: blocks[i]))
    ar = jnp.arange(BS)

    def one_chunk(args):
        cid, q_c, sel_c = args
        qpos = cid * QC + jnp.arange(QC)
        own = (cid * QC) // BS
        logits = []
        for s in range(n_sel):
            blk = sel_c[..., s]
            k_s = gather(kb, blk)
            kpos = blk[..., None] * BS + ar
            bias = table_t[hid, t5_bucket(qpos[:, None] - kpos)]
            lg = jnp.einsum('bhqd,bhqjd->bhqj', q_c, k_s) + bias
            logits.append(jnp.where((blk < own)[..., None], lg, -jnp.inf))
        k_o = lax.dynamic_index_in_dim(kb, own, axis=2, keepdims=False)
        v_o = lax.dynamic_index_in_dim(vb, own, axis=2, keepdims=False)
        kpos_o = own * BS + ar
        bias_o = table_t[:, t5_bucket(qpos[:, None] - kpos_o[None, :])]
        lg_o = jnp.einsum('bhqd,bhjd->bhqj', q_c, k_o) + bias_o
        logits.append(jnp.where(kpos_o[None, :] <= qpos[:, None], lg_o, -jnp.inf))
        p = jax.nn.softmax(jnp.concatenate(logits, axis=-1), axis=-1)
        out = jnp.einsum('bhqj,bhje->bhqe', p[..., n_sel * BS:], v_o)
        for s in range(n_sel):
            v_s = gather(vb, sel_c[..., s])
            out = out + jnp.einsum('bhqj,bhqje->bhqe', p[..., s * BS:(s + 1) * BS], v_s)
        return out

    out = lax.map(one_chunk, (jnp.arange(nC, dtype=jnp.int32), qc, selc))
    out = jnp.moveaxis(out, 0, 2).reshape(B, H, S, dh)
    return jnp.swapaxes(out, 1, 2).reshape(B, S, H * dh)


def setup_inputs(seed: int = 0) -> dict:
    key = jax.random.key(seed)
    ks = jax.random.split(key, 20)

    def nrm(k, shape, scale):
        return jax.random.normal(k, shape, jnp.float32) * scale

    x = nrm(ks[0], (BATCH, SEQ, D_MODEL), 1.0)
    w_in = nrm(ks[1], (DEPTH, D_MODEL, D_IN), D_MODEL ** -0.5)
    i_b = nrm(ks[2], (DEPTH, 1, MLSTM_HEADS), 0.1)
    f_b = (jnp.linspace(3.0, 6.0, MLSTM_HEADS, dtype=jnp.float32)[None, None, :]
           + nrm(ks[3], (DEPTH, 1, MLSTM_HEADS), 0.1))
    mlstm_gate_b = jnp.concatenate([i_b, f_b], axis=1)
    mlstm_conv_w = nrm(ks[4], (DEPTH, MLSTM_CONV, 2 * MLSTM_QK_W), MLSTM_CONV ** -0.5)
    mlstm_conv_b = nrm(ks[5], (DEPTH, 2 * MLSTM_QK_W), 0.01)
    mlstm_norm_w = 1.0 + nrm(ks[6], (DEPTH, MLSTM_V_W), 0.02)
    w_branch_ret = nrm(ks[7], (DEPTH, RET_W, D_MODEL), RET_W ** -0.5)
    w_branch_mlstm = nrm(ks[8], (DEPTH, MLSTM_V_W, D_MODEL), MLSTM_V_W ** -0.5)
    w_branch_moba = nrm(ks[9], (DEPTH, MOBA_W, D_MODEL), MOBA_W ** -0.5)
    w_out = nrm(ks[10], (DEPTH, D_MODEL, D_MODEL), D_MODEL ** -0.5)
    norm_mix_w = 1.0 + nrm(ks[11], (DEPTH, D_MODEL), 0.02)
    norm_mlp_w = 1.0 + nrm(ks[12], (DEPTH, D_MODEL), 0.02)
    w_ff1 = nrm(ks[13], (DEPTH, D_MODEL, D_FF), D_MODEL ** -0.5)
    w_ff2 = nrm(ks[14], (DEPTH, D_FF, D_MODEL), D_FF ** -0.5)
    rel_bias = nrm(ks[15], (REL_BUCKETS, MOBA_HEADS), 0.5)
    final_norm_w = 1.0 + nrm(ks[16], (D_MODEL,), 0.02)
    return {"x": x, "w_in": w_in, "mlstm_gate_b": mlstm_gate_b, "mlstm_conv_w": mlstm_conv_w,
            "mlstm_conv_b": mlstm_conv_b, "mlstm_norm_w": mlstm_norm_w,
            "w_branch_ret": w_branch_ret, "w_branch_mlstm": w_branch_mlstm,
            "w_branch_moba": w_branch_moba, "w_out": w_out, "norm_mix_w": norm_mix_w,
            "norm_mlp_w": norm_mlp_w, "w_ff1": w_ff1, "w_ff2": w_ff2, "rel_bias": rel_bias,
            "final_norm_w": final_norm_w}


def reference(x, w_in, mlstm_gate_b, mlstm_conv_w, mlstm_conv_b, mlstm_norm_w,
              w_branch_ret, w_branch_mlstm, w_branch_moba, w_out, norm_mix_w,
              norm_mlp_w, w_ff1, w_ff2, rel_bias, final_norm_w):
    B, S, _ = x.shape
    offsets = np.cumsum(IN_SPLITS)[:-1].tolist()
    for l in range(DEPTH):
        h = rms_norm(x, norm_mix_w[l])
        proj = h @ w_in[l]
        (rq, rk, rv, rg, mq, mk, mv, mo, mi, mf, bq, bk, bv, gates) = jnp.split(proj, offsets, axis=-1)
        y_ret = retention(rq.reshape(B, S, RET_HEADS, RET_HEAD_DIM),
                          rk.reshape(B, S, RET_HEADS, RET_HEAD_DIM),
                          rv.reshape(B, S, RET_HEADS, RET_HEAD_DIM), rg)
        mqk = jax.nn.silu(causal_dwconv(jnp.concatenate([mq, mk], axis=-1), mlstm_conv_w[l], mlstm_conv_b[l]))
        mq_c, mk_c = jnp.split(mqk, 2, axis=-1)
        y_ml = mlstm(mq_c.reshape(B, S, MLSTM_HEADS, MLSTM_QK_DIM),
                     mk_c.reshape(B, S, MLSTM_HEADS, MLSTM_QK_DIM),
                     mv.reshape(B, S, MLSTM_HEADS, MLSTM_V_DIM), mo,
                     mi + mlstm_gate_b[l, 0], mf + mlstm_gate_b[l, 1], mlstm_norm_w[l])
        y_mb = moba(bq.reshape(B, S, MOBA_HEADS, MOBA_HEAD_DIM),
                    bk.reshape(B, S, MOBA_HEADS, MOBA_HEAD_DIM),
                    bv.reshape(B, S, MOBA_HEADS, MOBA_HEAD_DIM), rel_bias)
        g_ret, g_ml, g_mb = jnp.split(gates, 3, axis=-1)
        mixed = (jax.nn.sigmoid(g_ret) * (y_ret.astype(x.dtype) @ w_branch_ret[l])
                 + jax.nn.sigmoid(g_ml) * (y_ml.astype(x.dtype) @ w_branch_mlstm[l])
                 + jax.nn.sigmoid(g_mb) * (y_mb.astype(x.dtype) @ w_branch_moba[l]))
        x = x + mixed @ w_out[l]
        h2 = rms_norm(x, norm_mlp_w[l])
        x = x + jnp.square(jax.nn.relu(h2 @ w_ff1[l])) @ w_ff2[l]
    return rms_norm(x, final_norm_w)
```

```cpp
#include <hip/hip_runtime.h>
#include <cstdio>
#include <cstdint>

#ifndef MK_NTEAM
#define MK_NTEAM 8
#endif

namespace pg8 {
#define PG8_LAS __attribute__((address_space(3)))
#define PG8_GAS __attribute__((address_space(1)))
typedef unsigned short bf16_t;
typedef short bf16x8 __attribute__((ext_vector_type(8)));
typedef float f32x4 __attribute__((ext_vector_type(4)));
typedef unsigned u32x4 __attribute__((ext_vector_type(4)));
typedef unsigned u32x2 __attribute__((ext_vector_type(2)));
typedef int v4i32 __attribute__((ext_vector_type(4)));
typedef int v8i32 __attribute__((ext_vector_type(8)));
constexpr int BM = 256, BK = 64, HALF = 128, HTB = HALF * BK * 2, STAGE_BYTES = 8 * HTB, NXCD = 8 / MK_NTEAM, WGM = 4;

__host__ __device__ __forceinline__ int lds_byte(int r, int c) { const int st = (r >> 4) * 2 + (c >> 5), rr = r & 15, cc = c & 31, ob = rr * 64 + cc * 2; return st * 1024 + (ob ^ (((ob >> 9) & 1) << 5)); }
__host__ __device__ __forceinline__ void stage_rc(int b, int& R, int& C) { const int st = b / 1024, sb = b % 1024, swz = sb ^ (((sb >> 9) & 1) << 5); R = (st >> 1) * 16 + swz / 64; C = (st & 1) * 32 + (swz % 64) / 2; }
__host__ __device__ __forceinline__ int perm32(int rho) { const int n = rho >> 4, i = rho & 15; return 8 * (i >> 2) + 4 * n + (i & 3); }

struct Unit { int pm, pn, sub; };
struct Gemm { const bf16_t* A; const bf16_t* Bt; int K; size_t subA, subB; int lda; };

struct StaticOrder {
    int nM, nN, nwg, G, c;
    __host__ __device__ void init(int M, int N, int G_, int c_) { nM = M / BM; nN = N / BM; nwg = nM * nN; G = G_; c = c_; }
    __host__ __device__ bool tile(long L, Unit& u) const {
        if (L >= nwg) return false;
        int wgid = (int)L; { const int q = nwg / NXCD, r = nwg % NXCD, xcd = wgid % NXCD, off = wgid / NXCD; wgid = (xcd < r ? xcd * (q + 1) : r * (q + 1) + (xcd - r) * q) + off; }
        const int nig = WGM * nN, gid = wgid / nig, fm = gid * WGM, gsz = (nM - fm) < WGM ? (nM - fm) : WGM;
        u.pm = fm + ((wgid % nig) % gsz); u.pn = (wgid % nig) / gsz; u.sub = 0; return true;
    }
    __host__ __device__ bool next(int i, Unit& u) const { return tile((long)i * G + c, u); }
    __device__ __forceinline__ void a_ready(const Unit&) const {}
    __device__ __forceinline__ void done(const Unit&) const {}
};
struct PairOrder : StaticOrder {
    __host__ __device__ bool next(int i, Unit& u) const { const int j = i >> 1; if (!tile((long)j * G + c, u)) return false; u.sub = i & 1; return true; }
};
struct RevOrder : StaticOrder {
    __host__ __device__ bool next(int i, Unit& u) const { if (!tile((long)i * G + c, u)) return false; u.pm = nM - 1 - u.pm; return true; }
};
struct TripleOrder : StaticOrder {
    __host__ __device__ bool next(int i, Unit& u) const { const int j = i / 3; if (!tile((long)j * G + c, u)) return false; u.sub = i - 3 * j; return true; }
};

__device__ __forceinline__ unsigned cvt_pk_bf16(float lo, float hi) { unsigned r; asm volatile("v_cvt_pk_bf16_f32 %0, %1, %2" : "=v"(r) : "v"(lo), "v"(hi)); return r; }
__device__ __forceinline__ float sigmoidf_fast(float x) { return __builtin_amdgcn_rcpf(1.0f + __builtin_amdgcn_exp2f(-1.4426950408889634f * x)); }
__device__ __forceinline__ float bf_lo(unsigned u) { return __uint_as_float(u << 16); }
__device__ __forceinline__ float bf_hi(unsigned u) { return __uint_as_float(u & 0xffff0000u); }


__device__ __forceinline__ float epi_log2_gamma(int h) { const float x = __builtin_amdgcn_exp2f(-5.0f - (float)h); const float x2 = x * x;
    return -(x + x2 * (0.5f + x * (1.f / 3.f) + x2 * (0.25f + x * 0.2f + x2 * (1.f / 6.f)))) * 1.4426950408889634f; }
template <bool ROT>
struct EpiProj {
    static constexpr bool PERM = true; static constexpr bool CHAIN = false;
    bf16_t* O; int ldc; int pn_off;
    __device__ __forceinline__ void operator()(const f32x4 (&acc)[2][2][4][2], const Unit& u, int wr, int wc, int fr, int fq) const {
        const int ct = u.pn + pn_off; int act = 0;
        const int row0 = u.pm * BM + wr * 64 + fr, col0 = ct * BM + wc * 32 + 8 * fq;
        if (ct >= 12 && ct < 16) act = 1; else if ((ct >= 24 && ct < 28) || ct >= 40) act = 2;
        if (ROT && ct < 8) {
            const float inv0 = __builtin_amdgcn_exp2f(-(float)(16 * wc + 4 * fq) * (13.287712379549449f / 64.f)) * 0.15915494309189535f;
            constexpr float RS[4] = {1.0f, 0.8659643233600653f, 0.7498942093324559f, 0.6493816315762113f};
            const float l2g0 = epi_log2_gamma(((ct & 3) << 1)), l2g1 = epi_log2_gamma(((ct & 3) << 1) + 1);
#pragma unroll
            for (int ai = 0; ai < 2; ++ai)
#pragma unroll
                for (int m = 0; m < 4; ++m) { const int row = row0 + ai * HALF + m * 16; const int t = row & 2047; bf16_t* rowp = O + (size_t)row * ldc + col0;
                    const float sc0 = (ct < 4) ? 0.08838834764831845f : __builtin_amdgcn_exp2f(-(float)(t & 63) * l2g0), sc1 = (ct < 4) ? 0.08838834764831845f : __builtin_amdgcn_exp2f(-(float)(t & 63) * l2g1);
                    u32x4 w0, w1;
#pragma unroll
                    for (int e = 0; e < 4; ++e) { const float fr_ = __builtin_amdgcn_fractf((float)t * (inv0 * RS[e])); const float c_ = __builtin_amdgcn_cosf(fr_), s_ = __builtin_amdgcn_sinf(fr_);
                        const float a0 = acc[ai][0][m][e >> 1][(e & 1) * 2], b0 = acc[ai][0][m][e >> 1][(e & 1) * 2 + 1], a1 = acc[ai][1][m][e >> 1][(e & 1) * 2], b1 = acc[ai][1][m][e >> 1][(e & 1) * 2 + 1];
                        w0[e] = cvt_pk_bf16((a0 * c_ - b0 * s_) * sc0, (a0 * s_ + b0 * c_) * sc0);
                        w1[e] = cvt_pk_bf16((a1 * c_ - b1 * s_) * sc1, (a1 * s_ + b1 * c_) * sc1); }
                    *(PG8_GAS u32x4*)(rowp) = w0; *(PG8_GAS u32x4*)(rowp + HALF) = w1; }
            return;
        }
#pragma unroll
        for (int ai = 0; ai < 2; ++ai)
#pragma unroll
            for (int m = 0; m < 4; ++m) { bf16_t* rowp = O + (size_t)(row0 + ai * HALF + m * 16) * ldc + col0;
#pragma unroll
                for (int bj = 0; bj < 2; ++bj) { f32x4 v0 = acc[ai][bj][m][0], v1 = acc[ai][bj][m][1];
                    if (act) {
#pragma unroll
                        for (int j = 0; j < 4; ++j) { const float s0 = sigmoidf_fast(v0[j]), s1 = sigmoidf_fast(v1[j]); v0[j] = (act == 1) ? v0[j] * s0 : s0; v1[j] = (act == 1) ? v1[j] * s1 : s1; } }
                    if (ct >= 40) {
                        unsigned t0[4], t1[4];
#pragma unroll
                        for (int j = 0; j < 4; ++j) { t0[j] = __float_as_uint(v0[j] * 255.f + 8388608.f); t1[j] = __float_as_uint(v1[j] * 255.f + 8388608.f); }
                        u32x2 w; w.x = __builtin_amdgcn_perm(__builtin_amdgcn_perm(t0[3], t0[2], 0x0c0c0400u), __builtin_amdgcn_perm(t0[1], t0[0], 0x0c0c0400u), 0x05040100u);
                        w.y = __builtin_amdgcn_perm(__builtin_amdgcn_perm(t1[3], t1[2], 0x0c0c0400u), __builtin_amdgcn_perm(t1[1], t1[0], 0x0c0c0400u), 0x05040100u);
                        *(PG8_GAS u32x2*)((PG8_GAS unsigned char*)(O + (size_t)(row0 + ai * HALF + m * 16) * ldc + 40 * BM) + (col0 - 40 * BM) + bj * HALF) = w;
                    } else {
                    u32x4 w; w.x = cvt_pk_bf16(v0[0], v0[1]); w.y = cvt_pk_bf16(v0[2], v0[3]); w.z = cvt_pk_bf16(v1[0], v1[1]); w.w = cvt_pk_bf16(v1[2], v1[3]);
                    *(PG8_GAS u32x4*)(rowp + bj * HALF) = w; } } }
    }
};
struct EpiRelu2 {
    static constexpr bool PERM = true; static constexpr bool CHAIN = false;
    bf16_t* O; int ldc; const PG8_LAS float* rt;
    __device__ __forceinline__ void operator()(const f32x4 (&acc)[2][2][4][2], const Unit& u, int wr, int wc, int fr, int fq) const {
        const int row0 = u.pm * BM + wr * 64 + fr, col0 = u.pn * BM + wc * 32 + 8 * fq;
#pragma unroll
        for (int ai = 0; ai < 2; ++ai)
#pragma unroll
            for (int m = 0; m < 4; ++m) { bf16_t* rowp = O + (size_t)(row0 + ai * HALF + m * 16) * ldc + col0; const float rs = rt[row0 + ai * HALF + m * 16];
#pragma unroll
                for (int bj = 0; bj < 2; ++bj) { f32x4 v0 = acc[ai][bj][m][0], v1 = acc[ai][bj][m][1];
#pragma unroll
                    for (int j = 0; j < 4; ++j) { const float a = fmaxf(v0[j] * rs, 0.f), b = fmaxf(v1[j] * rs, 0.f); v0[j] = a * a; v1[j] = b * b; }
                    u32x4 w; w.x = cvt_pk_bf16(v0[0], v0[1]); w.y = cvt_pk_bf16(v0[2], v0[3]); w.z = cvt_pk_bf16(v1[0], v1[1]); w.w = cvt_pk_bf16(v1[2], v1[3]);
                    *(PG8_GAS u32x4*)(rowp + bj * HALF) = w; } }
    }
};
__device__ __forceinline__ float epi_sum4(float v, int a16, int a32) {
    v += __builtin_bit_cast(float, __builtin_amdgcn_ds_bpermute(a16, __builtin_bit_cast(int, v)));
    v += __builtin_bit_cast(float, __builtin_amdgcn_ds_bpermute(a32, __builtin_bit_cast(int, v)));
    return v; }
template <bool BASE_F32, bool NORM = false>
struct EpiResB {
    static constexpr bool PERM = true; static constexpr bool CHAIN = false;
    const void* base; bf16_t* out; int ldb, ldo;
    bf16_t* H; const float* gain; float* ssp; int ldh;
    __device__ __forceinline__ void emit(f32x4 v0, f32x4 v1, size_t off, size_t hoff, const f32x4 (&gn)[2], float& ss) const {
        u32x4 w; w.x = cvt_pk_bf16(v0[0], v0[1]); w.y = cvt_pk_bf16(v0[2], v0[3]); w.z = cvt_pk_bf16(v1[0], v1[1]); w.w = cvt_pk_bf16(v1[2], v1[3]);
        *(PG8_GAS u32x4*)(out + off) = w;
        if constexpr (NORM) {
            const float x0 = bf_lo(w.x), x1 = bf_hi(w.x), x2 = bf_lo(w.y), x3 = bf_hi(w.y), x4 = bf_lo(w.z), x5 = bf_hi(w.z), x6 = bf_lo(w.w), x7 = bf_hi(w.w);
            ss += ((x0 * x0 + x1 * x1) + (x2 * x2 + x3 * x3)) + ((x4 * x4 + x5 * x5) + (x6 * x6 + x7 * x7));
            (void)gn; (void)hoff; }
    }
    __device__ __forceinline__ void operator()(const f32x4 (&acc)[2][2][4][2], const Unit& u, int wr, int wc, int fr, int fq) const {
        const int row0 = u.pm * BM + wr * 64 + fr, col0 = u.pn * BM + wc * 32 + 8 * fq;
        f32x4 gn[2][2]; const int a16 = ((fr + 16 * fq) ^ 16) << 2, a32 = ((fr + 16 * fq) ^ 32) << 2;

        if constexpr (BASE_F32) {
            const float* bs = (const float*)base;
            f32x4 cur[2][2], nxt[2][2];
#define EPI_LD(dst, g_) do { const size_t off_ = (size_t)(row0 + ((g_) >> 2) * HALF + ((g_) & 3) * 16) * ldb + col0; _Pragma("unroll") for (int bj = 0; bj < 2; ++bj) _Pragma("unroll") for (int n = 0; n < 2; ++n) dst[bj][n] = *(const PG8_GAS f32x4*)(bs + off_ + bj * HALF + n * 4); } while (0)
            EPI_LD(cur, 0);
#pragma unroll
            for (int g = 0; g < 8; ++g) { const int ai = g >> 2, m = g & 3;
                if (g + 1 < 8) EPI_LD(nxt, g + 1);
                const size_t off = (size_t)(row0 + ai * HALF + m * 16) * ldo + col0;
                float ss = 0.f; const size_t hoff = (size_t)(row0 + ai * HALF + m * 16) * ldh + col0;
#pragma unroll
                for (int bj = 0; bj < 2; ++bj) { const f32x4 v0 = cur[bj][0] + acc[ai][bj][m][0], v1 = cur[bj][1] + acc[ai][bj][m][1];
                    emit(v0, v1, off + bj * HALF, hoff + bj * HALF, gn[bj], ss); }
                if constexpr (NORM) { ss = epi_sum4(ss, a16, a32); if (fq == 0) *(PG8_GAS float*)(ssp + (size_t)(row0 + ai * HALF + m * 16) * 32 + u.pn * 4 + wc) = ss; }
                asm volatile("" ::: "memory");
#pragma unroll
                for (int bj = 0; bj < 2; ++bj)
#pragma unroll
                    for (int n = 0; n < 2; ++n) cur[bj][n] = nxt[bj][n]; }
#undef EPI_LD
        } else {
            const bf16_t* bs = (const bf16_t*)base;
            u32x4 cur[2], nxt[2];
#define EPI_LD(dst, g_) do { const size_t off_ = (size_t)(row0 + ((g_) >> 2) * HALF + ((g_) & 3) * 16) * ldb + col0; _Pragma("unroll") for (int bj = 0; bj < 2; ++bj) dst[bj] = *(const PG8_GAS u32x4*)(bs + off_ + bj * HALF); } while (0)
            EPI_LD(cur, 0);
#pragma unroll
            for (int g = 0; g < 8; ++g) { const int ai = g >> 2, m = g & 3;
                if (g + 1 < 8) EPI_LD(nxt, g + 1);
                const size_t off = (size_t)(row0 + ai * HALF + m * 16) * ldo + col0;
                float ss = 0.f; const size_t hoff = (size_t)(row0 + ai * HALF + m * 16) * ldh + col0;
#pragma unroll
                for (int bj = 0; bj < 2; ++bj) { const u32x4 pw = cur[bj]; f32x4 v0 = acc[ai][bj][m][0], v1 = acc[ai][bj][m][1];
                    v0[0] += bf_lo(pw.x); v0[1] += bf_hi(pw.x); v0[2] += bf_lo(pw.y); v0[3] += bf_hi(pw.y); v1[0] += bf_lo(pw.z); v1[1] += bf_hi(pw.z); v1[2] += bf_lo(pw.w); v1[3] += bf_hi(pw.w);
                    emit(v0, v1, off + bj * HALF, hoff + bj * HALF, gn[bj], ss); }
                if constexpr (NORM) { ss = epi_sum4(ss, a16, a32); if (fq == 0) *(PG8_GAS float*)(ssp + (size_t)(row0 + ai * HALF + m * 16) * 32 + u.pn * 4 + wc) = ss; }
                asm volatile("" ::: "memory");
#pragma unroll
                for (int bj = 0; bj < 2; ++bj) cur[bj] = nxt[bj]; }
#undef EPI_LD
        }
    }
};
struct EpiBranch {
    static constexpr bool PERM = true; static constexpr bool CHAIN = true;
    bf16_t* O; int ldo; const bf16_t* G; int ldg; int gstride; int fsub;
    __device__ __forceinline__ bool mid(f32x4 (&acc)[2][2][4][2], const Unit& u, int wr, int wc, int fr, int fq) const {
        if (fsub >= 0 || u.sub != 0) return false;
        const int row0 = u.pm * BM + wr * 64 + fr, col0 = u.pn * BM + wc * 32 + 8 * fq;
        constexpr int RD = 2;
        u32x2 g0q[RD][2], g1q[RD][2];
        const PG8_GAS unsigned char* gb = (const PG8_GAS unsigned char*)(G + (size_t)row0 * ldg) + col0;
        const unsigned rstep = (unsigned)ldg * 2u;
#define EPI_LDG(slot, g_) do { const PG8_GAS unsigned char* gp_ = gb + (unsigned)(((g_) >> 2) * HALF + ((g_) & 3) * 16) * rstep; _Pragma("unroll") for (int bj = 0; bj < 2; ++bj) { \
            g0q[slot][bj] = *(const PG8_GAS u32x2*)(gp_ + bj * HALF); g1q[slot][bj] = *(const PG8_GAS u32x2*)(gp_ + gstride + bj * HALF); } } while (0)
#pragma unroll
        for (int s = 0; s < RD; ++s) EPI_LDG(s, s);
#pragma unroll
        for (int g = 0; g < 8; ++g) { const int ai = g >> 2, m = g & 3, sl = g % RD;
#pragma unroll
            for (int bj = 0; bj < 2; ++bj) { const u32x2 a = g0q[sl][bj], c = g1q[sl][bj];
#pragma unroll
                for (int n = 0; n < 2; ++n) { const unsigned aw = n ? a.y : a.x, cw = n ? c.y : c.x;
#pragma unroll
                    for (int j = 0; j < 4; ++j) { const float k0 = (float)((aw >> (8 * j)) & 0xffu), k1 = fmaxf((float)((cw >> (8 * j)) & 0xffu), 1.f);
                        acc[ai][bj][m][n][j] *= k0 * __builtin_amdgcn_rcpf(k1); } } }
            if (g + RD < 8) EPI_LDG(sl, g + RD);
            asm volatile("" ::: "memory"); }
#undef EPI_LDG
        return true;
    }
    __device__ __forceinline__ void operator()(const f32x4 (&acc)[2][2][4][2], const Unit& u, int wr, int wc, int fr, int fq) const {
        const int row0 = u.pm * BM + wr * 64 + fr, col0 = u.pn * BM + wc * 32 + 8 * fq; const int sub = fsub >= 0 ? fsub : 1; const bool pair = fsub < 0;
        u32x2 gc[2], gn[2]; u32x4 pc[2], pn[2];
#define EPI_LD(gd, pd, g_) do { const size_t r_ = (size_t)(row0 + ((g_) >> 2) * HALF + ((g_) & 3) * 16); _Pragma("unroll") for (int bj = 0; bj < 2; ++bj) { gd[bj] = *(const PG8_GAS u32x2*)((const PG8_GAS unsigned char*)(G + r_ * ldg) + sub * gstride + col0 + bj * HALF); \
            pd[bj] = (u32x4){0u, 0u, 0u, 0u}; if (pair) pd[bj] = *(const PG8_GAS u32x4*)(O + r_ * ldo + col0 + bj * HALF); } } while (0)
        EPI_LD(gc, pc, 0);
#pragma unroll
        for (int g = 0; g < 8; ++g) { const int ai = g >> 2, m = g & 3; const size_t r = (size_t)(row0 + ai * HALF + m * 16);
            if (g + 1 < 8) EPI_LD(gn, pn, g + 1);
#pragma unroll
            for (int bj = 0; bj < 2; ++bj) { u32x2 gw = gc[bj]; const u32x4 pw = pc[bj];
                float k[8] = {(float)(gw.x & 0xffu), (float)((gw.x >> 8) & 0xffu), (float)((gw.x >> 16) & 0xffu), (float)(gw.x >> 24), (float)(gw.y & 0xffu), (float)((gw.y >> 8) & 0xffu), (float)((gw.y >> 16) & 0xffu), (float)(gw.y >> 24)};
                if (pair) {
#pragma unroll
                    for (int j = 0; j < 8; ++j) k[j] = fmaxf(k[j], 1.f); }
                f32x4 v0 = acc[ai][bj][m][0] * (1.f / 255.f), v1 = acc[ai][bj][m][1] * (1.f / 255.f);
                v0[0] = v0[0] * k[0] + bf_lo(pw.x); v0[1] = v0[1] * k[1] + bf_hi(pw.x); v0[2] = v0[2] * k[2] + bf_lo(pw.y); v0[3] = v0[3] * k[3] + bf_hi(pw.y);
                v1[0] = v1[0] * k[4] + bf_lo(pw.z); v1[1] = v1[1] * k[5] + bf_hi(pw.z); v1[2] = v1[2] * k[6] + bf_lo(pw.w); v1[3] = v1[3] * k[7] + bf_hi(pw.w);
                u32x4 w; w.x = cvt_pk_bf16(v0[0], v0[1]); w.y = cvt_pk_bf16(v0[2], v0[3]); w.z = cvt_pk_bf16(v1[0], v1[1]); w.w = cvt_pk_bf16(v1[2], v1[3]);
                *(PG8_GAS u32x4*)(O + r * ldo + col0 + bj * HALF) = w; }
            asm volatile("" ::: "memory");
#pragma unroll
            for (int bj = 0; bj < 2; ++bj) { gc[bj] = gn[bj]; pc[bj] = pn[bj]; } }
#undef EPI_LD
    }
};

template <class Epi, class Sched, bool ALIGN_EPI = false, bool SP2 = false, bool FP8 = false>
__device__ __forceinline__ void gemm_phase(PG8_LAS unsigned char* lds, const Gemm g, const Sched& S, const Epi& E) {
    int tid_ = threadIdx.x; asm volatile("" : "+v"(tid_));
    const int tid = tid_, wid = __builtin_amdgcn_readfirstlane(tid >> 6), lane = tid & 63, wr = wid >> 2, wc = wid & 3, fr = lane & 15, fq = lane >> 4;
    const int K = g.K, nt = K / BK, lda = g.lda ? g.lda : g.K;
    unsigned voffA[2], voffB[2];
#pragma unroll
    for (int i = 0; i < 2; ++i) { int R, C; stage_rc(tid * 16 + i * 8192, R, C); const int Rb = Epi::PERM ? ((R & ~31) + perm32(R & 31)) : R;
        voffA[i] = (unsigned)(R * lda + C) * 2u; voffB[i] = (unsigned)(Rb * K + C) * 2u; }
    const size_t kstep = (size_t)(BK * 2);
    const size_t hstep = (size_t)HALF * K * 2, hstepA = (size_t)HALF * lda * 2;
    const size_t tstep = 2 * hstep, tstepA = 2 * hstepA;
    const unsigned ldsw = (unsigned)wid * 1024u;
    const int aoff = lds_byte(wr * 64 + fr, fq * 8), boff = lds_byte(wc * 32 + fr, fq * 8);
#define PG8_SA(b, h) (((b) * 2 + (h)) * HTB)
#define PG8_SB(b, h) ((4 + (b) * 2 + (h)) * HTB)
#define PG8_STAGE(bufoff, gbase, voff) do { _Pragma("unroll") for (int _i = 0; _i < 2; ++_i) \
        __builtin_amdgcn_global_load_lds((const unsigned*)((const char*)(gbase) + (voff)[_i]), (PG8_LAS unsigned*)(lds + (bufoff) + ldsw + _i * 8192), 16, 0, 0); } while (0)
#define PG8_LDA(dst, b, h) do { _Pragma("unroll") for (int m = 0; m < 4; ++m) { if constexpr (FP8) { const v4i32 lo_ = *(const PG8_LAS v4i32*)(lds + PG8_SA(b, h) + aoff + m * 2048), hi_ = *(const PG8_LAS v4i32*)(lds + PG8_SA(b, h) + aoff + m * 2048 + 1024); dst##8[m] = __builtin_shufflevector(lo_, hi_, 0, 1, 2, 3, 4, 5, 6, 7); } \
        else { _Pragma("unroll") for (int k = 0; k < 2; ++k) dst[m][k] = *(const PG8_LAS bf16x8*)(lds + PG8_SA(b, h) + aoff + m * 2048 + k * 1024); } } } while (0)
#define PG8_LDB(dst, b, h) do { _Pragma("unroll") for (int n = 0; n < 2; ++n) { if constexpr (FP8) { const v4i32 lo_ = *(const PG8_LAS v4i32*)(lds + PG8_SB(b, h) + boff + n * 2048), hi_ = *(const PG8_LAS v4i32*)(lds + PG8_SB(b, h) + boff + n * 2048 + 1024); dst##8[n] = __builtin_shufflevector(lo_, hi_, 0, 1, 2, 3, 4, 5, 6, 7); } \
        else { _Pragma("unroll") for (int k = 0; k < 2; ++k) dst[n][k] = *(const PG8_LAS bf16x8*)(lds + PG8_SB(b, h) + boff + n * 2048 + k * 1024); } } } while (0)
#define PG8_MMA(ai, bj, At, Bt) do { __builtin_amdgcn_s_setprio(1); _Pragma("unroll") for (int m = 0; m < 4; ++m) _Pragma("unroll") for (int n = 0; n < 2; ++n) { \
        if constexpr (FP8) asm volatile("v_mfma_scale_f32_16x16x128_f8f6f4 %0, %1, %2, %0, %3, %4 op_sel_hi:[0,0,0]" : "+v"(acc[ai][bj][m][n]) : "v"(Bt##8[n]), "v"(At##8[m]), "v"(sc_w8), "v"(sc_a8));   \
        else { _Pragma("unroll") for (int k = 0; k < 2; ++k) acc[ai][bj][m][n] = __builtin_amdgcn_mfma_f32_16x16x32_bf16(Bt[n][k], At[m][k], acc[ai][bj][m][n], 0, 0, 0); } } \
        __builtin_amdgcn_s_setprio(0); } while (0)
#define PG8_WAIT_V(n) asm volatile("s_waitcnt vmcnt(" #n ")" ::: "memory")
#define PG8_WAIT_L(n) asm volatile("s_waitcnt lgkmcnt(" #n ")" ::: "memory")
#define PG8_BAR __builtin_amdgcn_s_barrier()
#define PG8_SCHED __builtin_amdgcn_sched_barrier(0)
#define PG8_UA(u) ((const char*)g.A + (size_t)(u).pm * tstepA + (size_t)(u).sub * g.subA)
#define PG8_UB(u) ((const char*)g.Bt + (size_t)(u).pn * tstep + (size_t)(u).sub * g.subB)
    Unit cur, nxt; int ui = 0;
    if (!S.next(0, cur)) return;
    f32x4 acc[2][2][4][2];
#pragma unroll
    for (int a = 0; a < 2; ++a)
#pragma unroll
        for (int b = 0; b < 2; ++b)
#pragma unroll
            for (int m = 0; m < 4; ++m)
#pragma unroll
                for (int n = 0; n < 2; ++n) acc[a][b][m][n] = (f32x4){0.f, 0.f, 0.f, 0.f};
    bf16x8 At[4][2], B0[2][2], B1[2][2];
    v8i32 At8[4], B08[2], B18[2];
    const int sc_w8 = 0x79797979, sc_a8 = 0x7f7f7f7f;
    const char* cA = PG8_UA(cur); const char* cB = PG8_UB(cur);
    S.a_ready(cur);
    if constexpr (SP2) {
        PG8_STAGE(PG8_SB(0, 0), cB, voffB); PG8_STAGE(PG8_SB(0, 1), cB + hstep, voffB); PG8_STAGE(PG8_SA(0, 0), cA, voffA); PG8_STAGE(PG8_SA(0, 1), cA + hstepA, voffA);
        if (wr == 1) PG8_BAR;
        PG8_WAIT_V(2); PG8_BAR;
        PG8_STAGE(PG8_SB(1, 0), cB + kstep, voffB); PG8_STAGE(PG8_SA(1, 0), cA + kstep, voffA); PG8_STAGE(PG8_SB(1, 1), cB + hstep + kstep, voffB);
        PG8_WAIT_V(6); PG8_BAR;
    } else {
        PG8_STAGE(PG8_SB(0, 0), cB, voffB); PG8_STAGE(PG8_SA(0, 0), cA, voffA); PG8_STAGE(PG8_SB(0, 1), cB + hstep, voffB); PG8_STAGE(PG8_SA(0, 1), cA + hstepA, voffA);
        if (wr == 1) PG8_BAR;
        PG8_WAIT_V(4); PG8_BAR;
        PG8_STAGE(PG8_SB(1, 0), cB + kstep, voffB); PG8_STAGE(PG8_SA(1, 0), cA + kstep, voffA); PG8_STAGE(PG8_SB(1, 1), cB + hstep + kstep, voffB);
        PG8_WAIT_V(6); PG8_BAR;
    }
    for (;;) {
        const bool has_next = S.next(ui + 1, nxt);
        const char* nA = has_next ? PG8_UA(nxt) : cA; const char* nB = has_next ? PG8_UB(nxt) : cB;
        for (int t = 0; t < nt; t += 2) {
            const bool last = (t == nt - 2);
            const char* a1 = cA + (size_t)(t + 1) * kstep;
            const char* a2 = last ? nA : cA + (size_t)(t + 2) * kstep; const char* b2 = last ? nB : cB + (size_t)(t + 2) * kstep;
            const char* a3 = a2 + kstep; const char* b3 = b2 + kstep;
            if (last && has_next) S.a_ready(nxt);
            if constexpr (SP2) {
            PG8_LDB(B0, 0, 0); PG8_LDB(B1, 0, 1); PG8_SCHED; PG8_LDA(At, 0, 0); PG8_STAGE(PG8_SA(1, 1), a1 + hstepA, voffA);
            PG8_WAIT_V(8); PG8_WAIT_L(0); PG8_BAR; PG8_MMA(0, 0, At, B0); PG8_MMA(0, 1, At, B1); PG8_BAR; PG8_SCHED;
            PG8_LDA(At, 0, 1); PG8_STAGE(PG8_SB(0, 0), b2, voffB); PG8_STAGE(PG8_SB(0, 1), b2 + hstep, voffB); PG8_STAGE(PG8_SA(0, 0), a2, voffA);
            PG8_WAIT_V(8); PG8_WAIT_L(0); PG8_BAR; PG8_MMA(1, 0, At, B0); PG8_MMA(1, 1, At, B1); PG8_BAR; PG8_SCHED;
            PG8_LDB(B0, 1, 0); PG8_LDB(B1, 1, 1); PG8_SCHED; PG8_LDA(At, 1, 0); PG8_STAGE(PG8_SA(0, 1), a2 + hstepA, voffA);
            PG8_WAIT_V(8); PG8_WAIT_L(0); PG8_BAR; PG8_MMA(0, 0, At, B0); PG8_MMA(0, 1, At, B1); PG8_BAR; PG8_SCHED;
            PG8_LDA(At, 1, 1); PG8_STAGE(PG8_SB(1, 0), b3, voffB); PG8_STAGE(PG8_SB(1, 1), b3 + hstep, voffB); PG8_STAGE(PG8_SA(1, 0), a3, voffA);
            PG8_WAIT_V(8); PG8_WAIT_L(0); PG8_BAR; PG8_MMA(1, 0, At, B0); PG8_MMA(1, 1, At, B1); PG8_BAR; PG8_SCHED;
            } else {
            PG8_LDB(B0, 0, 0); PG8_SCHED; PG8_LDA(At, 0, 0); PG8_STAGE(PG8_SA(1, 1), a1 + hstepA, voffA);
            PG8_WAIT_L(8); PG8_BAR; PG8_WAIT_L(0); PG8_MMA(0, 0, At, B0); PG8_BAR; PG8_SCHED;
            PG8_LDB(B1, 0, 1); PG8_STAGE(PG8_SB(0, 0), b2, voffB);
            PG8_BAR; PG8_WAIT_L(0); PG8_MMA(0, 1, At, B1); PG8_BAR;
            PG8_LDA(At, 0, 1); PG8_STAGE(PG8_SA(0, 0), a2, voffA);
            PG8_BAR; PG8_WAIT_L(0); PG8_MMA(1, 0, At, B0); PG8_BAR; PG8_SCHED;
            PG8_STAGE(PG8_SB(0, 1), b2 + hstep, voffB);
            PG8_WAIT_V(6); PG8_BAR; PG8_MMA(1, 1, At, B1); PG8_BAR;
            PG8_LDB(B0, 1, 0); PG8_SCHED; PG8_LDA(At, 1, 0); PG8_STAGE(PG8_SA(0, 1), a2 + hstepA, voffA);
            PG8_WAIT_L(8); PG8_BAR; PG8_WAIT_L(0); PG8_MMA(0, 0, At, B0); PG8_BAR; PG8_SCHED;
            PG8_LDB(B1, 1, 1); PG8_STAGE(PG8_SB(1, 0), b3, voffB);
            PG8_BAR; PG8_WAIT_L(0); PG8_MMA(0, 1, At, B1); PG8_BAR;
            PG8_LDA(At, 1, 1); PG8_STAGE(PG8_SA(1, 0), a3, voffA);
            PG8_BAR; PG8_WAIT_L(0); PG8_MMA(1, 0, At, B0); PG8_BAR; PG8_SCHED;
            PG8_STAGE(PG8_SB(1, 1), b3 + hstep, voffB);
            PG8_WAIT_V(6); PG8_BAR; PG8_MMA(1, 1, At, B1); PG8_BAR;
            }
        }
        if constexpr (FP8) asm volatile("s_nop 15\n\ts_nop 15" ::: "memory");
        if constexpr (ALIGN_EPI) { if (wr == 0) PG8_BAR; }
        bool keep = false;
        if constexpr (Epi::CHAIN) keep = E.mid(acc, cur, wr, wc, fr, fq);
        if (!keep) E(acc, cur, wr, wc, fr, fq);
        S.done(cur);
        if (!has_next) break;
        if (!keep)
#pragma unroll
        for (int a = 0; a < 2; ++a)
#pragma unroll
            for (int b = 0; b < 2; ++b)
#pragma unroll
                for (int m = 0; m < 4; ++m)
#pragma unroll
                    for (int n = 0; n < 2; ++n) acc[a][b][m][n] = (f32x4){0.f, 0.f, 0.f, 0.f};
        cur = nxt; cA = nA; cB = nB; ++ui;
        if constexpr (ALIGN_EPI) { if (wr == 1) PG8_BAR; }
    }
    PG8_WAIT_V(0);
    if constexpr (!ALIGN_EPI) { if (wr == 0) PG8_BAR; }
    PG8_BAR;
#undef PG8_SA
#undef PG8_SB
#undef PG8_STAGE
#undef PG8_LDA
#undef PG8_LDB
#undef PG8_MMA
#undef PG8_WAIT_V
#undef PG8_WAIT_L
#undef PG8_BAR
#undef PG8_SCHED
#undef PG8_UA
#undef PG8_UB
}
}

using pg8::bf_lo; using pg8::bf_hi; using pg8::cvt_pk_bf16; using pg8::sigmoidf_fast;

constexpr int NWAVES = 8;
constexpr int DM = 2048, BATCH = 16, SEQ = 2048, DEPTH = 2, DFF = 8192;
constexpr int DIN_SRC = 16392;
constexpr int NPROJ = 16384, NP16 = 6144, NP8 = NPROJ - NP16;
constexpr float W8_SCALE = 64.f;
constexpr int NTEAM = MK_NTEAM, GPT = 2, XPT = 8 / NTEAM;
constexpr int GB = BATCH / (NTEAM * GPT), MG = GB * SEQ, NGROUP = BATCH / GB;
constexpr int NIT = DEPTH * GPT;
constexpr int C_RQ = 0, C_RK = 1024, C_RV = 2048, C_RG = 3072, C_MQ = 4096, C_MK = 4608, C_MV = 5120, C_MO = 6144, C_BQ = 7168, C_BK = 8192, C_BV = 9216, C_GATE = 10240;
constexpr int SRC_GATECOL = 7168;
constexpr float EPS = 1e-6f;
constexpr float LOG2E = 1.4426950408889634f;
constexpr float QSCALE = 0.08838834764831845f;


constexpr size_t MiB = 1u << 20;
constexpr size_t WS_CTL = 0, CTL_ZERO_BYTES = 2 * MiB;
constexpr size_t SZ_WIN = (size_t)NP16 * DM * 2, SZ_WIN8 = (size_t)NP8 * DM, SZ_WBR = (size_t)3 * DM * 1024 * 2, SZ_WOUT = (size_t)DM * DM * 2, SZ_WFF = (size_t)DFF * DM * 2;
constexpr size_t WS_WIN = 2 * MiB;
constexpr size_t WS_WBR = WS_WIN + DEPTH * SZ_WIN;
constexpr size_t WS_WOUT = WS_WBR + DEPTH * SZ_WBR;
constexpr size_t WS_WFF1 = WS_WOUT + DEPTH * SZ_WOUT;
constexpr size_t WS_WFF2 = WS_WFF1 + DEPTH * SZ_WFF;
constexpr size_t WS_WG = WS_WFF2 + DEPTH * SZ_WFF;
constexpr size_t WS_WIN8 = WS_WG + 1 * MiB;
constexpr size_t WS_WBR8 = WS_WIN8 + DEPTH * SZ_WIN8;
constexpr size_t SZ_WBR8 = (size_t)DM * 1024;
constexpr size_t WS_ACT = WS_WBR8 + DEPTH * SZ_WBR8;
constexpr size_t WS_HB = 0;
constexpr size_t WS_MIXED = WS_HB;
constexpr size_t WS_GP = WS_HB + (size_t)MG * DM * 2;
constexpr size_t WS_A2 = WS_GP + (size_t)MG * 8 * 4;
constexpr size_t WS_NM = WS_A2 + (size_t)MG * 4 * 4;
constexpr size_t WS_KSC = WS_NM + (size_t)MG * 4 * 4;
constexpr size_t WS_BMAX = WS_KSC + (size_t)MG * 4 * 4;
constexpr size_t WS_KMEAN = WS_BMAX + 64 * 1024;
constexpr size_t WS_MQK = WS_KMEAN + (size_t)GB * 8 * 8 * 128 * 4;
constexpr size_t WS_Y = WS_MQK + (size_t)MG * 1024 * 2;
constexpr size_t WS_MST_IMG = WS_HB;
constexpr size_t WS_MST_Z = WS_HB + 4 * MiB;
constexpr size_t WS_MST_R = WS_MST_Z + 64 * 1024;
static_assert(WS_MST_R + 4096 <= WS_HB + (size_t)MG * DM * 2, "mLSTM state images fit in the hidden-state buffer");
constexpr size_t WS_HRAW = WS_Y;
constexpr size_t WS_SSP = WS_Y + (size_t)MG * DM * 2;
static_assert((size_t)MG * DM * 2 + (size_t)MG * 32 * 4 <= (size_t)3 * MG * 1024 * 2, "HRAW + SSP fit in Y");
constexpr size_t WS_HB8 = WS_Y + (size_t)3 * MG * 1024 * 2;
constexpr size_t WS_PROJ = WS_HB8 + (size_t)MG * DM;
constexpr size_t TEAM_STRIDE = WS_PROJ + (size_t)MG * NPROJ * 2;
constexpr size_t WS_END = WS_ACT + NTEAM * TEAM_STRIDE;
static_assert(WS_END <= (size_t)1020 * MiB, "workspace map");
constexpr int CW_TMO = 0, CW_CODE = 1;
constexpr int CW_Q2 = 2048, CW_FLAG = 1536;
constexpr int CW_BAR = 4096;

constexpr int RING_OFF = 0, RING_BYTES = 131072;
constexpr int LDSCTL_OFF = RING_BYTES, MISC_OFF = LDSCTL_OFF + 320;
constexpr int LDS_BYTES = 147456;
constexpr int RSTD_OFF = LDSCTL_OFF + 1024;
static_assert(MISC_OFF + 128 <= RSTD_OFF && RSTD_OFF + 2048 * 4 <= LDS_BYTES, "LDS map");

#define GAS __attribute__((address_space(1)))
#define LAS __attribute__((address_space(3)))
typedef unsigned short bf16;
typedef unsigned v4u __attribute__((ext_vector_type(4)));
typedef unsigned v2u __attribute__((ext_vector_type(2)));
typedef float f32x4 __attribute__((ext_vector_type(4)));
typedef __bf16 bfp2 __attribute__((ext_vector_type(2)));
typedef GAS unsigned gu32;
#define RLX_AGENT __ATOMIC_RELAXED, __HIP_MEMORY_SCOPE_AGENT
#define LDS_WAIT() asm volatile("s_waitcnt lgkmcnt(0)" ::: "memory")
#define VM_WAIT() asm volatile("s_waitcnt vmcnt(0)" ::: "memory")
__device__ __forceinline__ unsigned f2bf(float f) { unsigned u = __builtin_bit_cast(unsigned, f); return (u + 0x7fffu + ((u >> 16) & 1u)) >> 16; }
__device__ __forceinline__ unsigned pk2(float lo, float hi) { return f2bf(lo) | (f2bf(hi) << 16); }
__device__ __forceinline__ float dot2bf(unsigned a, unsigned b, float c) { return __builtin_amdgcn_fdot2_f32_bf16(__builtin_bit_cast(bfp2, a), __builtin_bit_cast(bfp2, b), c, false); }

#define XB_TMO      128
#define XB_XCNT(j)  (256  + 64 * (j))
#define XB_XSUB(j)  (1280 + 64 * (j))
#define XB_XGEN(j)  (2304 + 64 * (j))
#define XB_TOP      3328
#define XB_TOPGEN   3392
#define XCD_BAR_WORDS 3456
#define XB_SPIN_CAP (1u << 18)

__device__ __forceinline__ unsigned xb_ld(unsigned* p)              { return __hip_atomic_load(p, __ATOMIC_RELAXED, __HIP_MEMORY_SCOPE_AGENT); }
__device__ __forceinline__ unsigned xb_add(unsigned* p, unsigned v) { return __hip_atomic_fetch_add(p, v, __ATOMIC_RELAXED, __HIP_MEMORY_SCOPE_AGENT); }
__device__ __forceinline__ unsigned xb_xcc_id() { return (unsigned)__builtin_amdgcn_s_getreg((3 << 11) | 20) & 0xFu; }
#define XB_SPIN(cond, bar) do { unsigned _sp = 0; while (cond) { __builtin_amdgcn_s_sleep(1); \
    if ((++_sp & 255u) == 0u) { if (xb_ld(&(bar)[XB_TMO])) break; if (_sp > XB_SPIN_CAP) { atomicAdd(&(bar)[XB_TMO], 1u); break; } } } } while (0)

struct XcdBarrier { unsigned* bar; unsigned x; volatile LAS unsigned* st; unsigned G; };

__device__ __forceinline__ XcdBarrier xcd_barrier_post(unsigned* bar, volatile LAS unsigned* st, unsigned G) {
    XcdBarrier b; b.bar = bar; b.x = xb_xcc_id(); b.st = st; b.G = G;
    if (threadIdx.x == 0) (void)xb_add(&bar[XB_XCNT(b.x)], 1u);
    return b;
}
__device__ __forceinline__ void xcd_barrier_complete(unsigned* bar, unsigned x, unsigned& nloc, unsigned& nx, const unsigned G) {
    unsigned sum, cnt, mine, sp = 0u;
    for (;;) {
        sum = 0u; cnt = 0u; mine = 0u;
#pragma unroll
        for (unsigned j = 0; j < 16; ++j) { const unsigned c = xb_ld(&bar[XB_XCNT(j)]); sum += c; cnt += (c > 0u) ? 1u : 0u; mine = (j == x) ? c : mine; }
        if (sum == G) break;
        __builtin_amdgcn_s_sleep(1);
        if ((++sp & 255u) == 0u) { if (xb_ld(&bar[XB_TMO])) break; if (sp > XB_SPIN_CAP) { atomicAdd(&bar[XB_TMO], 1u); break; } }
    }
    nloc = mine > 0u ? mine : 1u; nx = cnt > 0u ? cnt : 1u;
}
__device__ __forceinline__ void xcd_barrier(const XcdBarrier& b) {
    asm volatile("s_waitcnt vmcnt(0)" ::: "memory");
    __syncthreads();
    if (threadIdx.x == 0) {
        unsigned* bar = b.bar;
        __builtin_amdgcn_s_waitcnt(0);
        unsigned nloc = b.st[0], nx = b.st[1];
        if (nloc == 0u) { xcd_barrier_complete(bar, b.x, nloc, nx, b.G); b.st[0] = nloc; b.st[1] = nx; }
        const unsigned old = xb_add(&bar[XB_XSUB(b.x)], 1u);
        const unsigned gen = old / nloc;
        if (old + 1u == (gen + 1u) * nloc) {
            __builtin_amdgcn_fence(__ATOMIC_RELEASE, "agent");
            asm volatile("s_waitcnt vmcnt(0)" ::: "memory");
            const unsigned og = xb_add(&bar[XB_TOP], 1u);
            const unsigned tg = og / nx;
            if (og + 1u == (tg + 1u) * nx) xb_add(&bar[XB_TOPGEN], 1u);
            else XB_SPIN(xb_ld(&bar[XB_TOPGEN]) == tg, bar);
            __builtin_amdgcn_fence(__ATOMIC_ACQUIRE, "agent");
            xb_add(&bar[XB_XGEN(b.x)], 1u);
            asm volatile("s_waitcnt vmcnt(0)" ::: "memory");
        } else {
            XB_SPIN(xb_ld(&bar[XB_XGEN(b.x)]) == gen, bar);
            __builtin_amdgcn_fence(__ATOMIC_ACQUIRE, "agent");
            asm volatile("s_waitcnt vmcnt(0)" ::: "memory");
        }
    }
    __syncthreads();
}

struct Frame {
    LAS unsigned char* lds;
    volatile LAS unsigned* MISC;
    gu32* ctl;
    int tid, lane, wave;
    int vcu, G;
    int bidx, team;
    unsigned char* ws;
    unsigned char* wsw;
    float* out;
};
__device__ __forceinline__ Frame relocal(const Frame& F0) { Frame F = F0; int t = threadIdx.x; asm volatile("" : "+v"(t)); F.tid = t; F.lane = t & 63; F.wave = __builtin_amdgcn_readfirstlane(t >> 6);
    asm volatile("" : "+s"(F.ws)); asm volatile("" : "+s"(F.wsw)); asm volatile("" : "+s"(F.out)); return F; }
__device__ __forceinline__ unsigned char* opq(unsigned char* p) { asm volatile("" : "+s"(p)); return p; }
template <int X> __device__ __forceinline__ float swz_xor(float v) {
    return __uint_as_float((unsigned)__builtin_amdgcn_ds_swizzle((int)__float_as_uint(v), (X << 10) | 0x1f)); }
__device__ __forceinline__ float sum_xor32(float v) { auto r = __builtin_amdgcn_permlane32_swap(__float_as_uint(v), __float_as_uint(v), false, false); return __uint_as_float(r[0]) + __uint_as_float(r[1]); }
__device__ __forceinline__ float max_xor32(float v) { auto r = __builtin_amdgcn_permlane32_swap(__float_as_uint(v), __float_as_uint(v), false, false); return fmaxf(__uint_as_float(r[0]), __uint_as_float(r[1])); }
__device__ __forceinline__ float wave_sum(float v) { v += swz_xor<1>(v); v += swz_xor<2>(v); v += swz_xor<4>(v); v += swz_xor<8>(v); v += swz_xor<16>(v); return sum_xor32(v); }
__device__ __forceinline__ float wave_max(float v) { v = fmaxf(v, swz_xor<1>(v)); v = fmaxf(v, swz_xor<2>(v)); v = fmaxf(v, swz_xor<4>(v)); v = fmaxf(v, swz_xor<8>(v)); v = fmaxf(v, swz_xor<16>(v)); return max_xor32(v); }

__device__ __forceinline__ void p0_transpose_item(const float* W, int K, int N, int Nsrc, bool shift8, bf16* WT, LAS float* scr, int item, int lane, const float* kscale = nullptr) {
    const int nblk = N / 32, kb = item / nblk, nb = item % nblk, k0 = 64 * kb, n0 = 32 * nb;
    const int cp = n0 + (lane & 31);
    const int csrc = (shift8 && n0 < 2048) ? ((cp & ~127) + ((cp & 1) << 6) + ((cp & 127) >> 1)) : cp;
    float tv[32];
#pragma unroll
    for (int i = 0; i < 32; ++i) tv[i] = W[(size_t)(k0 + 2 * i + (lane >> 5)) * Nsrc + csrc];
    if (kscale) {
#pragma unroll
        for (int i = 0; i < 32; ++i) tv[i] *= kscale[k0 + 2 * i + (lane >> 5)]; }
#pragma unroll
    for (int i = 0; i < 32; ++i) scr[(2 * i + (lane >> 5)) * 33 + (lane & 31)] = tv[i];
    LDS_WAIT(); asm volatile("" ::: "memory");
    const int c = lane & 7;
#pragma unroll
    for (int j = 0; j < 4; ++j) { const int n = (lane >> 3) + 8 * j; const LAS float* s = scr + (8 * c) * 33 + n;
        v4u o; o.x = pk2(s[0 * 33], s[1 * 33]); o.y = pk2(s[2 * 33], s[3 * 33]); o.z = pk2(s[4 * 33], s[5 * 33]); o.w = pk2(s[6 * 33], s[7 * 33]);
        *(GAS v4u*)(WT + (size_t)(n0 + n) * K + k0 + 8 * c) = o; }
    LDS_WAIT(); asm volatile("" ::: "memory");
}

__device__ __forceinline__ unsigned pk4_fp8(float a, float b, float c, float d) { int w = 0; w = __builtin_amdgcn_cvt_pk_fp8_f32(a, b, w, false); w = __builtin_amdgcn_cvt_pk_fp8_f32(c, d, w, true); return (unsigned)w; }
__device__ __forceinline__ void p0_transpose_item_fp8(const float* W, int K, int N, int Nsrc, int srcoff, unsigned char* WT, LAS float* scr, int item, int lane, bool gatefix = true) {
    const int nblk = N / 32, kb = item / nblk, nb = item % nblk, k0 = 64 * kb, n0 = 32 * nb, ns0 = n0 + srcoff + ((gatefix && n0 + srcoff >= SRC_GATECOL) ? 8 : 0);
    float tv[32];
#pragma unroll
    for (int i = 0; i < 32; ++i) tv[i] = W[(size_t)(k0 + 2 * i + (lane >> 5)) * Nsrc + ns0 + (lane & 31)];
#pragma unroll
    for (int i = 0; i < 32; ++i) scr[(2 * i + (lane >> 5)) * 33 + (lane & 31)] = tv[i];
    LDS_WAIT(); asm volatile("" ::: "memory");
    const int n = lane >> 1, kh = (lane & 1) * 32; const LAS float* s = scr + kh * 33 + n;
    v4u o0, o1;
    o0.x = pk4_fp8(s[0 * 33] * W8_SCALE, s[1 * 33] * W8_SCALE, s[2 * 33] * W8_SCALE, s[3 * 33] * W8_SCALE); o0.y = pk4_fp8(s[4 * 33] * W8_SCALE, s[5 * 33] * W8_SCALE, s[6 * 33] * W8_SCALE, s[7 * 33] * W8_SCALE);
    o0.z = pk4_fp8(s[8 * 33] * W8_SCALE, s[9 * 33] * W8_SCALE, s[10 * 33] * W8_SCALE, s[11 * 33] * W8_SCALE); o0.w = pk4_fp8(s[12 * 33] * W8_SCALE, s[13 * 33] * W8_SCALE, s[14 * 33] * W8_SCALE, s[15 * 33] * W8_SCALE);
    o1.x = pk4_fp8(s[16 * 33] * W8_SCALE, s[17 * 33] * W8_SCALE, s[18 * 33] * W8_SCALE, s[19 * 33] * W8_SCALE); o1.y = pk4_fp8(s[20 * 33] * W8_SCALE, s[21 * 33] * W8_SCALE, s[22 * 33] * W8_SCALE, s[23 * 33] * W8_SCALE);
    o1.z = pk4_fp8(s[24 * 33] * W8_SCALE, s[25 * 33] * W8_SCALE, s[26 * 33] * W8_SCALE, s[27 * 33] * W8_SCALE); o1.w = pk4_fp8(s[28 * 33] * W8_SCALE, s[29 * 33] * W8_SCALE, s[30 * 33] * W8_SCALE, s[31 * 33] * W8_SCALE);
    GAS v4u* dst = (GAS v4u*)(WT + (size_t)(n0 + n) * K + k0 + kh); dst[0] = o0; dst[1] = o1;
    LDS_WAIT(); asm volatile("" ::: "memory");
}
struct Args { const float* in[16]; float* out; unsigned char* ws; };
typedef const __attribute__((address_space(4))) Args* KArgs;
__device__ __forceinline__ KArgs kargs() { KArgs p = (KArgs)__builtin_amdgcn_kernarg_segment_ptr(); asm volatile("" : "+s"(p)); return p; }

constexpr int PRO_I_IN16 = (DM / 64) * (NP16 / 32), PRO_I_IN = (DM / 64) * (NPROJ / 32), PRO_I_BR = (1024 / 64) * (DM / 32), PRO_I_OUT = (DM / 64) * (DM / 32), PRO_I_F1 = (DM / 64) * (DFF / 32), PRO_I_F2 = (DFF / 64) * (DM / 32);
constexpr int PRO_PER_L = PRO_I_IN + 3 * PRO_I_BR + PRO_I_OUT + PRO_I_F1 + PRO_I_F2;
__device__ __forceinline__ void phase_prologue(const Frame& F0, KArgs a, int i0, int i1, int wg, int nwg, bool gates) { Frame F = relocal(F0);
    LAS float* scr = (LAS float*)(F.lds + RING_OFF + F.wave * 16384);
    const int gw = wg * NWAVES + F.wave, NGW = nwg * NWAVES;
    constexpr int I_IN = PRO_I_IN, I_BR = PRO_I_BR, I_OUT = PRO_I_OUT, I_F1 = PRO_I_F1, PER_L = PRO_PER_L;
    for (int it = i0 + gw; it < i1; it += NGW) {
        const int l = it / PER_L; int r = it - l * PER_L;
        if (r < PRO_I_IN16) { p0_transpose_item(a->in[1] + (size_t)l * DM * DIN_SRC, DM, NP16, DIN_SRC, true, (bf16*)(F.wsw + WS_WIN + l * SZ_WIN), scr, r, F.lane); continue; }
        if (r < I_IN) { p0_transpose_item_fp8(a->in[1] + (size_t)l * DM * DIN_SRC, DM, NP8, DIN_SRC, NP16, F.wsw + WS_WIN8 + l * SZ_WIN8, scr, r - PRO_I_IN16, F.lane); continue; } r -= I_IN;
        if (r < 3 * I_BR) { const int br = r / I_BR; r -= br * I_BR;
            if (br == 2) { p0_transpose_item_fp8(a->in[8] + (size_t)l * 1024 * DM, 1024, DM, DM, 0, F.wsw + WS_WBR8 + l * SZ_WBR8, scr, r, F.lane, false); continue; }
            p0_transpose_item(a->in[6 + br] + (size_t)l * 1024 * DM, 1024, DM, DM, false, (bf16*)(F.wsw + WS_WBR + l * SZ_WBR + (size_t)br * DM * 1024 * 2), scr, r, F.lane); continue; } r -= 3 * I_BR;
        if (r < I_OUT) { p0_transpose_item(a->in[9] + (size_t)l * DM * DM, DM, DM, DM, false, (bf16*)(F.wsw + WS_WOUT + l * SZ_WOUT), scr, r, F.lane); continue; } r -= I_OUT;
        if (r < I_F1) { p0_transpose_item(a->in[12] + (size_t)l * DM * DFF, DM, DFF, DFF, false, (bf16*)(F.wsw + WS_WFF1 + l * SZ_WFF), scr, r, F.lane, a->in[11] + (size_t)l * DM); continue; } r -= I_F1;
        p0_transpose_item(a->in[13] + (size_t)l * DFF * DM, DFF, DM, DM, false, (bf16*)(F.wsw + WS_WFF2 + l * SZ_WFF), scr, r, F.lane);
    }
    if (gates) {
        float* WG = (float*)(F.wsw + WS_WG);
        for (int i = gw * 64 + F.lane; i < DEPTH * 8 * DM; i += NGW * 64) { const int l = i / (8 * DM), j = (i / DM) % 8, k = i % DM;
            WG[i] = a->in[1][(size_t)l * DM * DIN_SRC + (size_t)k * DIN_SRC + SRC_GATECOL + j]; } }
}

__device__ __forceinline__ void row_load(const float* xrow, int lane, f32x4 (&v)[8]) { const GAS f32x4* xr = (const GAS f32x4*)xrow + lane;
#pragma unroll
    for (int j = 0; j < 8; ++j) v[j] = xr[64 * j]; }
__device__ __forceinline__ void rms_apply(const float* gain, int lane, f32x4 (&hv)[8]) {
    float s = 0.f;
#pragma unroll
    for (int j = 0; j < 8; ++j) s += (hv[j].x * hv[j].x + hv[j].y * hv[j].y) + (hv[j].z * hv[j].z + hv[j].w * hv[j].w);
    const float rstd = 1.0f / sqrtf(wave_sum(s) * (1.f / DM) + EPS);
    const GAS f32x4* gr = (const GAS f32x4*)gain + lane;
#pragma unroll
    for (int j = 0; j < 8; ++j) hv[j] = hv[j] * rstd * gr[64 * j];
}
__device__ __forceinline__ void store_row_bf16(bf16* orow, int lane, const f32x4 (&hv)[8]) {
    GAS unsigned long long* o8 = (GAS unsigned long long*)orow + lane;
#pragma unroll
    for (int j = 0; j < 8; ++j) o8[64 * j] = (unsigned long long)pk2(hv[j].x, hv[j].y) | ((unsigned long long)pk2(hv[j].z, hv[j].w) << 32);
}
__device__ __forceinline__ void rms_apply_g(const f32x4 (&g)[8], f32x4 (&hv)[8]) {
    float s = 0.f;
#pragma unroll
    for (int j = 0; j < 8; ++j) s += (hv[j].x * hv[j].x + hv[j].y * hv[j].y) + (hv[j].z * hv[j].z + hv[j].w * hv[j].w);
    const float rstd = 1.0f / sqrtf(wave_sum(s) * (1.f / DM) + EPS);
#pragma unroll
    for (int j = 0; j < 8; ++j) hv[j] = hv[j] * rstd * g[j];
}
__device__ __forceinline__ float reduce8(const float (&a)[8], int lane) {
    const bool b0 = lane & 1, b1 = lane & 2, b2 = lane & 4;
    float b[4], c[2];
#pragma unroll
    for (int i = 0; i < 4; ++i) { const float send = b0 ? a[i] : a[i + 4], keep = b0 ? a[i + 4] : a[i]; b[i] = keep + swz_xor<1>(send); }
#pragma unroll
    for (int i = 0; i < 2; ++i) { const float send = b1 ? b[i] : b[i + 2], keep = b1 ? b[i + 2] : b[i]; c[i] = keep + swz_xor<2>(send); }
    float d; { const float send = b2 ? c[0] : c[1], keep = b2 ? c[1] : c[0]; d = keep + swz_xor<4>(send); }
    d += swz_xor<8>(d); d += swz_xor<16>(d); return sum_xor32(d);
}
template <bool BF> struct RowBuf;
template <> struct RowBuf<false> { f32x4 r[8];
    __device__ __forceinline__ void load(const float* slot, int lane) { const GAS f32x4* p = (const GAS f32x4*)slot + lane;
#pragma unroll
        for (int j = 0; j < 8; ++j) r[j] = p[64 * j]; }
    __device__ __forceinline__ void get(f32x4 (&v)[8]) const {
#pragma unroll
        for (int j = 0; j < 8; ++j) v[j] = r[j]; } };
template <> struct RowBuf<true> { v2u r[8];
    __device__ __forceinline__ void load(const float* slot, int lane) { const GAS v2u* p = (const GAS v2u*)slot + lane;
#pragma unroll
        for (int j = 0; j < 8; ++j) r[j] = p[64 * j]; }
    __device__ __forceinline__ void get(f32x4 (&v)[8]) const {
#pragma unroll
        for (int j = 0; j < 8; ++j) { v[j].x = bf_lo(r[j].x); v[j].y = bf_hi(r[j].x); v[j].z = bf_lo(r[j].y); v[j].w = bf_hi(r[j].y); } } };
template <bool BF>
__device__ __forceinline__ void phase_norm1(const Frame& F0, KArgs a, int layer, const float* xsrc  ) { Frame F = relocal(F0);
    LAS float* wg = (LAS float*)(F.lds + RING_OFF);
    const float* WG = (const float*)(F.wsw + WS_WG) + (size_t)layer * 8 * DM;
    const float* gainp = a->in[10] + (size_t)layer * DM; const float* gb = a->in[2] + layer * 8;
    bf16* HB = (bf16*)(F.ws + WS_HB); float* GP = (float*)(F.ws + WS_GP);
    const int gw = F.vcu * NWAVES + F.wave, NGW = F.G * NWAVES;
    RowBuf<BF> ring[4];
#pragma unroll
    for (int s = 0; s < 4; ++s) ring[s].load(xsrc + (size_t)(gw + s * NGW < MG ? gw + s * NGW : gw) * DM, F.lane);
    for (int i = F.tid; i < 8 * DM / 4; i += NWAVES * 64) ((LAS f32x4*)wg)[i] = ((const GAS f32x4*)WG)[i];
    f32x4 g[8];
#pragma unroll
    for (int j = 0; j < 8; ++j) g[j] = ((const GAS f32x4*)gainp)[F.lane + 64 * j];
    const int gidx = 4 * (F.lane & 1) + 2 * ((F.lane >> 1) & 1) + ((F.lane >> 2) & 1);
    const float gbias = ((const GAS float*)gb)[gidx];
    __syncthreads();
#pragma unroll 1
    for (int m = gw; m < MG; m += 4 * NGW) {
#pragma unroll
        for (int s = 0; s < 4; s += 2) {
            const bool ok0 = m + s * NGW < MG, ok1 = m + (s + 1) * NGW < MG;
            const int m0 = ok0 ? m + s * NGW : m, m1 = ok1 ? m + (s + 1) * NGW : m;
            f32x4 x0[8], x1[8]; ring[s].get(x0); ring[s + 1].get(x1);
            const int n0 = m0 + 4 * NGW < MG ? m0 + 4 * NGW : m0, n1 = m1 + 4 * NGW < MG ? m1 + 4 * NGW : m1;
            if constexpr (BF) { ring[s].load(xsrc + (size_t)n0 * DM, F.lane); ring[s + 1].load(xsrc + (size_t)n1 * DM, F.lane); }
            rms_apply_g(g, x0); if (ok0) store_row_bf16(HB + (size_t)m0 * DM, F.lane, x0);
            if (ok0) { GAS unsigned* o8 = (GAS unsigned*)(F.ws + WS_HB8 + (size_t)m0 * DM) + F.lane;
#pragma unroll
              for (int j = 0; j < 8; ++j) o8[64 * j] = pk4_fp8(x0[j].x, x0[j].y, x0[j].z, x0[j].w); }
            rms_apply_g(g, x1); if (ok1) store_row_bf16(HB + (size_t)m1 * DM, F.lane, x1);
            if (ok1) { GAS unsigned* o8 = (GAS unsigned*)(F.ws + WS_HB8 + (size_t)m1 * DM) + F.lane;
#pragma unroll
              for (int j = 0; j < 8; ++j) o8[64 * j] = pk4_fp8(x1[j].x, x1[j].y, x1[j].z, x1[j].w); }
            float a0[8], a1[8];
#pragma unroll
            for (int q = 0; q < 8; ++q) { float s0 = 0.f, s1 = 0.f;
#pragma unroll
                for (int j = 0; j < 8; ++j) { const f32x4 w = ((const LAS f32x4*)(wg + q * DM))[F.lane + 64 * j];
                    s0 += (x0[j].x * w.x + x0[j].y * w.y) + (x0[j].z * w.z + x0[j].w * w.w);
                    s1 += (x1[j].x * w.x + x1[j].y * w.y) + (x1[j].z * w.z + x1[j].w * w.w); }
                a0[q] = s0; a1[q] = s1; asm volatile("" ::: "memory"); }
            const float r0 = reduce8(a0, F.lane), r1 = reduce8(a1, F.lane);
            if (F.lane < 8 && ok0) ((GAS float*)GP)[(size_t)m0 * 8 + gidx] = r0 + gbias;
            if (F.lane < 8 && ok1) ((GAS float*)GP)[(size_t)m1 * 8 + gidx] = r1 + gbias;
            if constexpr (!BF) { ring[s].load(xsrc + (size_t)n0 * DM, F.lane); ring[s + 1].load(xsrc + (size_t)n1 * DM, F.lane); }
        }
    }
    __syncthreads();
}
__device__ __forceinline__ void phase_norm2(const Frame& F0, KArgs a, int layer, const float* xsrc) { Frame F = relocal(F0);
    const float* gainp = a->in[11] + (size_t)layer * DM; bf16* HB = (bf16*)(F.ws + WS_HB);
    const int gw = F.vcu * NWAVES + F.wave, NGW = F.G * NWAVES;
    RowBuf<true> ring[4];
#pragma unroll
    for (int s = 0; s < 4; ++s) ring[s].load(xsrc + (size_t)(gw + s * NGW < MG ? gw + s * NGW : gw) * DM, F.lane);
    f32x4 g[8];
#pragma unroll
    for (int j = 0; j < 8; ++j) g[j] = ((const GAS f32x4*)gainp)[F.lane + 64 * j];
#pragma unroll 1
    for (int m = gw; m < MG; m += 4 * NGW) {
#pragma unroll
        for (int s = 0; s < 4; ++s) { const int mm = m + s * NGW; const bool ok = mm < MG;
            f32x4 x[8]; ring[s].get(x);
            ring[s].load(xsrc + (size_t)(mm + 4 * NGW < MG ? mm + 4 * NGW : gw) * DM, F.lane);
            rms_apply_g(g, x); if (ok) store_row_bf16(HB + (size_t)mm * DM, F.lane, x); }
    }
}
__device__ __forceinline__ void phase_final(const Frame& F0, KArgs a) { Frame F = relocal(F0);
    const float* gainp = a->in[15]; const int gw = F.vcu * NWAVES + F.wave, NGW = F.G * NWAVES;
    float* base = F.out + (size_t)F.team * GPT * MG * DM;
    constexpr int NR = GPT * MG;
    RowBuf<true> ring[4];
#pragma unroll
    for (int s = 0; s < 4; ++s) if (gw + s * NGW < NR) ring[s].load(base + (size_t)(gw + s * NGW) * DM, F.lane);
    f32x4 g[8];
#pragma unroll
    for (int j = 0; j < 8; ++j) g[j] = ((const GAS f32x4*)gainp)[F.lane + 64 * j];
#pragma unroll 1
    for (int m = gw; m < NR; m += 4 * NGW) {
#pragma unroll
        for (int s = 0; s < 4; ++s) { const int mm = m + s * NGW;
            if (mm >= NR) break;
            f32x4 x[8]; ring[s].get(x);
            if (mm + 4 * NGW < NR) ring[s].load(base + (size_t)(mm + 4 * NGW) * DM, F.lane);
            rms_apply_g(g, x);
            GAS f32x4* o = (GAS f32x4*)(base + (size_t)mm * DM) + F.lane;
#pragma unroll
            for (int j = 0; j < 8; ++j) o[64 * j] = x[j]; }
    }
}

__device__ __forceinline__ float log_sigmoid_f(float x) { return x >= 0.f ? -log1pf(expf(-x)) : x - log1pf(expf(x)); }
__device__ __forceinline__ void gate_scan(const Frame& F0, int bh) { Frame F = relocal(F0);
    const int b = bh >> 2, h = bh & 3, lane = F.lane, w = F.wave;
    const GAS float* GP = (const GAS float*)(F.ws + WS_GP) + (size_t)b * SEQ * 8;
    GAS float* A2 = (GAS float*)(F.ws + WS_A2) + (size_t)b * SEQ * 4; GAS float* NM = (GAS float*)(F.ws + WS_NM) + (size_t)b * SEQ * 4; GAS float* KSC = (GAS float*)(F.ws + WS_KSC) + (size_t)b * SEQ * 4;
    GAS float* BMAX = (GAS float*)(F.ws + WS_BMAX) + bh * 32;
    volatile LAS float* xs = (volatile LAS float*)(F.lds + RING_OFF);
    const int t0 = w * 256 + lane * 4;
    float c[4], li[4];
    float run = 0.f;
#pragma unroll
    for (int i = 0; i < 4; ++i) { li[i] = GP[(size_t)(t0 + i) * 8 + h]; run += log_sigmoid_f(GP[(size_t)(t0 + i) * 8 + 4 + h]); c[i] = run; }
    float off = 0.f, wtot;
    { float a_ = 0.f;
#pragma unroll
      for (int i = 0; i < 64; ++i) { off = (lane == i) ? a_ : off; a_ += __uint_as_float(__builtin_amdgcn_readlane(__float_as_uint(run), i)); }
      wtot = a_; }
    __syncthreads();
    if (lane == 0) xs[w] = wtot;
    __syncthreads();
#pragma unroll
    for (int i = 0; i < 8; ++i) { const float x = xs[i]; off += (i < w) ? x : 0.f; }
    float pmx = -__builtin_inff();
#pragma unroll
    for (int i = 0; i < 4; ++i) { c[i] += off; li[i] = li[i] - c[i]; pmx = fmaxf(pmx, li[i]); }
    float pre = -__builtin_inff(), wmx;
    { float a_ = -__builtin_inff();
#pragma unroll
      for (int i = 0; i < 64; ++i) { pre = (lane == i) ? a_ : pre; a_ = fmaxf(a_, __uint_as_float(__builtin_amdgcn_readlane(__float_as_uint(pmx), i))); }
      wmx = a_; }
    if (lane == 0) xs[8 + w] = wmx;
    __syncthreads();
#pragma unroll
    for (int i = 0; i < 8; ++i) { const float x = xs[8 + i]; pre = (i < w) ? fmaxf(pre, x) : pre; }
    float bmax = fmaxf(fmaxf(li[0], li[1]), fmaxf(li[2], li[3]));
    bmax = fmaxf(bmax, swz_xor<1>(bmax)); bmax = fmaxf(bmax, swz_xor<2>(bmax)); bmax = fmaxf(bmax, swz_xor<4>(bmax)); bmax = fmaxf(bmax, swz_xor<8>(bmax));
    if ((lane & 15) == 0) BMAX[w * 4 + (lane >> 4)] = bmax * LOG2E;
    float rm = pre;
#pragma unroll
    for (int i = 0; i < 4; ++i) { rm = fmaxf(rm, li[i]); const float mp = fmaxf(rm, 0.f); const size_t o = (size_t)(t0 + i) * 4 + h;
        A2[o] = -mp * LOG2E; NM[o] = expf(-(c[i] + mp)); KSC[o] = exp2f((li[i] - bmax) * LOG2E); }
    __syncthreads();
}

__device__ __forceinline__ float log2_gamma(int h) { const float x = exp2f(-5.0f - (float)h); const float x2 = x * x;
    return -(x + x2 * (0.5f + x * (1.f / 3.f) + x2 * (0.25f + x * 0.2f + x2 * (1.f / 6.f)))) * LOG2E; }
__device__ __forceinline__ void phase_prep(const Frame& F0, KArgs a, int layer) { Frame F = relocal(F0);
    bf16* PROJ = (bf16*)(F.ws + WS_PROJ);
    const int lane = F.lane;
    {
        LAS float* red = (LAS float*)(F.lds + RING_OFF);
        float* KM = (float*)(F.ws + WS_KMEAN);
        for (int task = F.vcu; task < GB * 8 * 8; task += F.G) {
            const int b = task >> 6, n = (task >> 3) & 7, h = task & 7;
            const int rg = F.tid >> 4, ch = F.tid & 15;
            float acc[8];
#pragma unroll
            for (int j = 0; j < 8; ++j) acc[j] = 0.f;
            v4u kw[8];
#pragma unroll
            for (int i = 0; i < 8; ++i) kw[i] = *(const GAS v4u*)(PROJ + (size_t)(b * SEQ + n * 256 + rg + 32 * i) * NPROJ + C_BK + h * 128 + ch * 8);
#pragma unroll
            for (int i = 0; i < 8; ++i) { const v4u w = kw[i];
                acc[0] += bf_lo(w.x); acc[1] += bf_hi(w.x); acc[2] += bf_lo(w.y); acc[3] += bf_hi(w.y); acc[4] += bf_lo(w.z); acc[5] += bf_hi(w.z); acc[6] += bf_lo(w.w); acc[7] += bf_hi(w.w); }
#pragma unroll
            for (int j = 0; j < 8; ++j) red[rg * 128 + ch * 8 + j] = acc[j];
            __syncthreads();
            if (F.tid < 128) { float s = 0.f;
#pragma unroll 8
                for (int r = 0; r < 32; ++r) s += red[r * 128 + F.tid];
                KM[(size_t)((b * 8 + h) * 8 + n) * 128 + F.tid] = s * (1.f / 256.f); }
            __syncthreads();
        }
    }
    const int gw = F.vcu * NWAVES + F.wave, NGW = F.G * NWAVES;
    {
        const float* cw = a->in[3] + (size_t)layer * 4 * 1024; const float* cb = a->in[4] + (size_t)layer * 1024;
        const float* KSC = (const float*)(F.ws + WS_KSC); bf16* MQK = (bf16*)(F.ws + WS_MQK);
        for (int task = gw; task < (MG / 16) * 2; task += NGW) {
            const int half = task & 1, row0 = (task >> 1) * 16, c0 = half * 512 + lane * 8, t0 = row0 & (SEQ - 1), hh = lane >> 4;
            float w[4][8], bias[8];
#pragma unroll
            for (int j = 0; j < 4; ++j)
#pragma unroll
                for (int e = 0; e < 8; ++e) w[j][e] = cw[j * 1024 + c0 + e];
#pragma unroll
            for (int e = 0; e < 8; ++e) bias[e] = cb[c0 + e];
            v4u xr[19];
#pragma unroll
            for (int r = 0; r < 19; ++r) { xr[r] = (v4u){0u, 0u, 0u, 0u}; if (t0 + r - 3 >= 0) xr[r] = *(const GAS v4u*)(PROJ + (size_t)(row0 + r - 3) * NPROJ + C_MQ + c0); }
            const float* kscp = KSC + (size_t)row0 * 4 + hh;
#pragma unroll
            for (int r = 0; r < 16; ++r) {
                const v4u v0 = xr[r], v1 = xr[r + 1], v2 = xr[r + 2], v3 = xr[r + 3];
                const float x0[8] = {bf_lo(v0.x), bf_hi(v0.x), bf_lo(v0.y), bf_hi(v0.y), bf_lo(v0.z), bf_hi(v0.z), bf_lo(v0.w), bf_hi(v0.w)};
                const float x1[8] = {bf_lo(v1.x), bf_hi(v1.x), bf_lo(v1.y), bf_hi(v1.y), bf_lo(v1.z), bf_hi(v1.z), bf_lo(v1.w), bf_hi(v1.w)};
                const float x2[8] = {bf_lo(v2.x), bf_hi(v2.x), bf_lo(v2.y), bf_hi(v2.y), bf_lo(v2.z), bf_hi(v2.z), bf_lo(v2.w), bf_hi(v2.w)};
                const float x3[8] = {bf_lo(v3.x), bf_hi(v3.x), bf_lo(v3.y), bf_hi(v3.y), bf_lo(v3.z), bf_hi(v3.z), bf_lo(v3.w), bf_hi(v3.w)};
                const float sc = half ? kscp[r * 4] : QSCALE;
                float y[8];
#pragma unroll
                for (int e = 0; e < 8; ++e) { const float z = bias[e] + w[0][e] * x0[e] + w[1][e] * x1[e] + w[2][e] * x2[e] + w[3][e] * x3[e]; y[e] = z * sigmoidf_fast(z) * sc; }
                v4u o; o.x = pk2(y[0], y[1]); o.y = pk2(y[2], y[3]); o.z = pk2(y[4], y[5]); o.w = pk2(y[6], y[7]);
                *(GAS v4u*)(MQK + (size_t)(row0 + r) * 1024 + c0) = o;
            }
        }
    }
}

__device__ __forceinline__ int t5_bucket(int n) { if (n < 16) return n; const int l = 16 + (int)(logf((float)n * (1.f / 16.f)) / logf(8.f) * 16.f); return l < 31 ? l : 31; }

namespace mx {
typedef short bf16x8 __attribute__((ext_vector_type(8)));
typedef short s16x4 __attribute__((ext_vector_type(4)));
typedef float f32x16 __attribute__((ext_vector_type(16)));
constexpr int VBUF = 32768, KBUF = 16384, V_OFF = 0, K_OFF = 65536, X_OFF = 98304;
constexpr int X_AL = 0, X_LI = 1024, X_SS = 2048, X_KML = 4096, X_BT = 8192, X_GT = 12288;
#define KSWZ(row, colB) ((row) * 256 + ((colB) ^ (((row) & 7) << 4)))
__device__ __forceinline__ int v_st(int k, int c) { const int kk = (k & ~0xC) | ((k & 4) << 1) | ((k & 8) >> 1); return ((kk >> 3) * 4 + (c >> 5)) * 512 + ((kk & 7) * 32 + (c & 31)) * 2; }
__device__ __forceinline__ int v_rd_base(int lane) { return ((lane & 3) << 3) | (((lane >> 2) & 3) << 6) | (((lane >> 4) & 1) << 5) | (((lane >> 5) & 1) << 8); }
constexpr int v_rd_off(int d0, int ks, int half) { return d0 * 512 + ks * 4096 + half * 2048; }
__device__ __forceinline__ int crow(int r, int hi) { return (r & 3) + 8 * (r >> 2) + 4 * hi; }
__device__ __forceinline__ unsigned cvtpk(float lo, float hi) { unsigned r; asm volatile("v_cvt_pk_bf16_f32 %0, %1, %2" : "=v"(r) : "v"(lo), "v"(hi)); return r; }
#define MX_PK4(P, B_, OUT) do { unsigned a0 = cvtpk(P[B_+0], P[B_+1]), a1 = cvtpk(P[B_+2], P[B_+3]);                          \
        unsigned b0 = cvtpk(P[B_+4], P[B_+5]), b1 = cvtpk(P[B_+6], P[B_+7]);                                             \
        auto r0 = __builtin_amdgcn_permlane32_swap(a0, b0, false, false); auto r1 = __builtin_amdgcn_permlane32_swap(a1, b1, false, false); \
        v4u w_ = {r0[0], r1[0], r0[1], r1[1]}; OUT = __builtin_bit_cast(bf16x8, w_); } while (0)
template <int KB>
__device__ __forceinline__ void qkt(f32x16& p0, f32x16& p1, LAS unsigned char* L, int r32, int hi, const bf16x8* qr) {
    p0 = f32x16{}; p1 = f32x16{};
    const LAS unsigned char* kb[4];
#pragma unroll
    for (int dd = 0; dd < 4; ++dd) kb[dd] = L + K_OFF + KB * KBUF + KSWZ(r32, (dd * 16 + hi * 8) * 2);
#pragma unroll
    for (int d0 = 0; d0 < 8; ++d0) { const LAS unsigned char* a = kb[d0 & 3] + (d0 >> 2) * 128;
        const bf16x8 b0 = *(const LAS bf16x8*)a;
        const bf16x8 b1 = *(const LAS bf16x8*)(a + 32 * 256);
        __builtin_amdgcn_s_setprio(1);
        p0 = __builtin_amdgcn_mfma_f32_32x32x16_bf16(b0, qr[d0], p0, 0, 0, 0);
        p1 = __builtin_amdgcn_mfma_f32_32x32x16_bf16(b1, qr[d0], p1, 0, 0, 0);
        __builtin_amdgcn_s_setprio(0); }
}
template <int VB>
__device__ __forceinline__ void pv_tile(f32x16* o, int vb0, bf16x8 pa0, bf16x8 pa1, bf16x8 pa2, bf16x8 pa3) {
#define MX_TRRD(dst, off) asm volatile("ds_read_b64_tr_b16 %0, %1 offset:%2" : "=&v"(dst) : "v"(vb0), "i"(off) : "memory")
#define MX_PV_D0(d0) do { s16x4 l0, l1, l2, l3, h0, h1, h2, h3; constexpr int b_ = V_OFF + VB * VBUF + v_rd_off(d0, 0, 0); \
        MX_TRRD(l0, b_); MX_TRRD(h0, b_ + 2048); MX_TRRD(l1, b_ + 4096); MX_TRRD(h1, b_ + 6144); MX_TRRD(l2, b_ + 8192); MX_TRRD(h2, b_ + 10240); MX_TRRD(l3, b_ + 12288); MX_TRRD(h3, b_ + 14336); \
        asm volatile("s_waitcnt lgkmcnt(0)" ::: "memory"); __builtin_amdgcn_sched_barrier(0); __builtin_amdgcn_s_setprio(1);   \
        o[d0] = __builtin_amdgcn_mfma_f32_32x32x16_bf16(pa0, (bf16x8){l0[0], l0[1], l0[2], l0[3], h0[0], h0[1], h0[2], h0[3]}, o[d0], 0, 0, 0);   \
        o[d0] = __builtin_amdgcn_mfma_f32_32x32x16_bf16(pa1, (bf16x8){l1[0], l1[1], l1[2], l1[3], h1[0], h1[1], h1[2], h1[3]}, o[d0], 0, 0, 0);   \
        o[d0] = __builtin_amdgcn_mfma_f32_32x32x16_bf16(pa2, (bf16x8){l2[0], l2[1], l2[2], l2[3], h2[0], h2[1], h2[2], h2[3]}, o[d0], 0, 0, 0);   \
        o[d0] = __builtin_amdgcn_mfma_f32_32x32x16_bf16(pa3, (bf16x8){l3[0], l3[1], l3[2], l3[3], h3[0], h3[1], h3[2], h3[3]}, o[d0], 0, 0, 0); __builtin_amdgcn_s_setprio(0); } while (0)
    MX_PV_D0(0); MX_PV_D0(1); MX_PV_D0(2); MX_PV_D0(3);
#undef MX_PV_D0
#undef MX_TRRD
}
struct MixArgs { unsigned char* ws; const float* rel_bias; const float* norm_w; };

template <int TYPE, bool CH = false>
__device__ __forceinline__ void mix_block(const MixArgs p, LAS unsigned char* L, int b, int h, int blk, unsigned* ctr = nullptr) {
    int tid_ = threadIdx.x; asm volatile("" : "+v"(tid_));
    const int tid = tid_, wid = __builtin_amdgcn_readfirstlane(tid >> 6), lane = tid & 63, r32 = lane & 31, hi = lane >> 5;
    constexpr int QROWS = (TYPE == 1) ? 128 : 256, HD = (TYPE == 1) ? 256 : 128;
    const int P0 = blk * QROWS, wrow = (TYPE == 1) ? (wid & 3) : wid, vhalf = (TYPE == 1) ? (wid >> 2) : 0;
    const int qlo = P0 + 32 * wrow, trow = qlo + r32;
    const size_t grow = (size_t)b * SEQ + trow;
    const bf16* PROJ = (const bf16*)(p.ws + WS_PROJ); const bf16* MQK = (const bf16*)(p.ws + WS_MQK);
    const bf16 *Qp, *Kp, *Vp; int ldq;
    if (TYPE == 0) { Qp = PROJ + C_RQ + h * 128; Kp = PROJ + C_RK + h * 128; Vp = PROJ + C_RV + h * 128; ldq = NPROJ; }
    else if (TYPE == 1) { Qp = MQK + h * 128; Kp = MQK + 512 + h * 128; Vp = PROJ + C_MV + h * 256; ldq = 1024; }
    else { Qp = PROJ + C_BQ + h * 128; Kp = PROJ + C_BK + h * 128; Vp = PROJ + C_BV + h * 128; ldq = NPROJ; }
    const int NT = (P0 + QROWS) / 64;
    bf16x8 qr[8];
#pragma unroll
    for (int d0 = 0; d0 < 8; ++d0) qr[d0] = *(const GAS bf16x8*)(Qp + grow * ldq + d0 * 16 + hi * 8);
    const int sr = tid >> 4, sc = (tid & 15) * 8, kws = KSWZ(sr, sc * 2), vst0 = v_st(sr, sc), vst1 = v_st(32 + sr, sc);
    const bf16* kg = Kp + ((size_t)b * SEQ + sr) * ldq + sc; const bf16* vg = Vp + ((size_t)b * SEQ + sr) * NPROJ + sc;
    v4u st_k0, st_k1, st_v0, st_v1, st_v2, st_v3;
#define MX_LOAD(kb_) do { st_k0 = *(const GAS v4u*)(kg + (size_t)(kb_) * ldq); st_k1 = *(const GAS v4u*)(kg + (size_t)((kb_) + 32) * ldq); \
        st_v0 = *(const GAS v4u*)(vg + (size_t)(kb_) * NPROJ); st_v1 = *(const GAS v4u*)(vg + (size_t)((kb_) + 32) * NPROJ); \
        if (TYPE == 1) { st_v2 = *(const GAS v4u*)(vg + (size_t)(kb_) * NPROJ + 128); st_v3 = *(const GAS v4u*)(vg + (size_t)((kb_) + 32) * NPROJ + 128); } } while (0)
#define MX_WRITE(bf) do { *(LAS v4u*)(L + K_OFF + (bf) * KBUF + kws) = st_k0; *(LAS v4u*)(L + K_OFF + (bf) * KBUF + kws + 32 * 256) = st_k1; \
        *(LAS v4u*)(L + V_OFF + (bf) * VBUF + vst0) = st_v0; *(LAS v4u*)(L + V_OFF + (bf) * VBUF + vst1) = st_v1; \
        if (TYPE == 1) { *(LAS v4u*)(L + V_OFF + (bf) * VBUF + 16384 + vst0) = st_v2; *(LAS v4u*)(L + V_OFF + (bf) * VBUF + 16384 + vst1) = st_v3; } } while (0)
    if (!CH) MX_LOAD(0);
    LAS float* al_l = (LAS float*)(L + X_OFF + X_AL) + wid * 32; LAS float* li_l = (LAS float*)(L + X_OFF + X_LI) + wid * 32;
    LAS float* kml = (LAS float*)(L + X_OFF + X_KML); LAS float* btab = (LAS float*)(L + X_OFF + X_BT);
    const int own = blk;
    if (TYPE == 2) {
        const float* KM = (const float*)(p.ws + WS_KMEAN) + (size_t)(b * 8 + h) * 8 * 128;
        for (int i = tid; i < own * 128; i += NWAVES * 64) kml[i] = KM[i];
        if (tid <= 128) btab[tid] = p.rel_bias[t5_bucket(tid) * 8 + h] * LOG2E;
    }
    float rowA = 0.f, l2g = 0.f;
    if (TYPE == 0) l2g = log2_gamma(h);
    if (TYPE == 1) rowA = ((const float*)(p.ws + WS_A2))[grow * 4 + h];
    const float* BMX = (const float*)(p.ws + WS_BMAX) + (b * 4 + h) * 32;
    if (!CH) { VM_WAIT(); MX_WRITE(0); }
    if (!CH) __syncthreads();
    unsigned selmask = 0u;
    if (TYPE == 2) {
        if (own <= 3) selmask = (1u << own) - 1u;
        else {
            LAS float* gt = (LAS float*)(L + X_OFF + X_GT) + (wid * 32 + r32) * 8;
#pragma unroll 1
            for (int n = 0; n < own; ++n) { float s = 0.f;
#pragma unroll
                for (int d0 = 0; d0 < 8; ++d0) { const f32x4 k0 = *(const LAS f32x4*)(kml + n * 128 + d0 * 16 + hi * 8), k1 = *(const LAS f32x4*)(kml + n * 128 + d0 * 16 + hi * 8 + 4);
                    const v4u qw = __builtin_bit_cast(v4u, qr[d0]);
                    s += bf_lo(qw.x) * k0.x + bf_hi(qw.x) * k0.y + bf_lo(qw.y) * k0.z + bf_hi(qw.y) * k0.w + bf_lo(qw.z) * k1.x + bf_hi(qw.z) * k1.y + bf_lo(qw.w) * k1.z + bf_hi(qw.w) * k1.w; }
                s = sum_xor32(s);
                if (hi == 0) gt[n] = s; }
            asm volatile("s_waitcnt lgkmcnt(0)" ::: "memory");
            float gate[8];
            { const f32x4 g0 = *(const LAS f32x4*)gt, g1 = *(const LAS f32x4*)(gt + 4);
              gate[0] = g0.x; gate[1] = g0.y; gate[2] = g0.z; gate[3] = g0.w; gate[4] = g1.x; gate[5] = g1.y; gate[6] = g1.z; gate[7] = g1.w; }
#pragma unroll
            for (int n = 0; n < 8; ++n) if (n >= own) gate[n] = -__builtin_inff();
#pragma unroll
            for (int n = 0; n < 8; ++n) { int rank = 0;
#pragma unroll
                for (int j = 0; j < 8; ++j) rank += (gate[j] > gate[n] || (gate[j] == gate[n] && j < n)) ? 1 : 0;
                if (n < own && rank < 3) selmask |= (1u << n); }
        }
    }
    const int vb0 = (int)(unsigned)(size_t)(L + vhalf * 16384) + v_rd_base(lane);
    f32x16 o[4] = {};
    float den = 0.f, m_reg = -1e30f, l_reg = 0.f;
    if (CH) {
        MX_LOAD(2 * blk * 64);
        if (blk > 0) {
            if (tid == 0) { unsigned sp = 0; while (__hip_atomic_load(ctr, __ATOMIC_RELAXED, __HIP_MEMORY_SCOPE_AGENT) < (unsigned)blk) { __builtin_amdgcn_s_sleep(2); if (++sp > (1u << 24)) break; }
                __builtin_amdgcn_fence(__ATOMIC_ACQUIRE, "agent"); asm volatile("s_waitcnt vmcnt(0)" ::: "memory"); }
            __syncthreads();
            const bf16* img = (const bf16*)(p.ws + WS_MST_IMG) + ((size_t)(h * 16 + blk) * 128 + sr) * 256 + sc;
#pragma unroll
            for (int tau = 0; tau < 2; ++tau) {
                const v4u t0 = *(const GAS v4u*)(img + (size_t)(64 * tau) * 256), t1 = *(const GAS v4u*)(img + (size_t)(64 * tau + 32) * 256);
                const v4u t2 = *(const GAS v4u*)(img + (size_t)(64 * tau) * 256 + 128), t3 = *(const GAS v4u*)(img + (size_t)(64 * tau + 32) * 256 + 128);
                *(LAS v4u*)(L + V_OFF + tau * VBUF + vst0) = t0; *(LAS v4u*)(L + V_OFF + tau * VBUF + vst1) = t1;
                *(LAS v4u*)(L + V_OFF + tau * VBUF + 16384 + vst0) = t2; *(LAS v4u*)(L + V_OFF + tau * VBUF + 16384 + vst1) = t3; }
            if (tid < 128) kml[tid] = ((const float*)(p.ws + WS_MST_Z))[(h * 16 + blk) * 128 + tid];
            const float Rref = ((const float*)(p.ws + WS_MST_R))[h * 16 + blk];
            const float fac = __builtin_amdgcn_exp2f(rowA + Rref);
            if (hi == 0) al_l[r32] = fac;
            __syncthreads();
            pv_tile<0>(o, vb0, qr[0], qr[1], qr[2], qr[3]);
            pv_tile<1>(o, vb0, qr[4], qr[5], qr[6], qr[7]);
            float dz = 0.f;
#pragma unroll
            for (int d0 = 0; d0 < 8; ++d0) { const f32x4 z0 = *(const LAS f32x4*)(kml + d0 * 16 + hi * 8), z1 = *(const LAS f32x4*)(kml + d0 * 16 + hi * 8 + 4);
                const v4u qw = __builtin_bit_cast(v4u, qr[d0]);
                dz += bf_lo(qw.x) * z0.x + bf_hi(qw.x) * z0.y + bf_lo(qw.y) * z0.z + bf_hi(qw.y) * z0.w + bf_lo(qw.z) * z1.x + bf_hi(qw.z) * z1.y + bf_lo(qw.w) * z1.z + bf_hi(qw.w) * z1.w; }
            den = dz * fac;
            asm volatile("s_waitcnt lgkmcnt(0)" ::: "memory");
#pragma unroll
            for (int r = 0; r < 16; ++r) { const float a_ = al_l[crow(r, hi)]; o[0][r] *= a_; o[1][r] *= a_; o[2][r] *= a_; o[3][r] *= a_; }
            __syncthreads();
        }
        VM_WAIT(); MX_WRITE(0);
        __syncthreads();
    }
    const float b31 = (TYPE == 2) ? btab[128] : 0.f;
    constexpr float C2 = QSCALE * LOG2E, THR = 8.f;
#define MX_STEP(t_, KB) do { const int t = (t_), kb = t * 64; \
        if (t + 1 < NT) MX_LOAD(kb + 64); \
        if (kb <= qlo + 31) { \
            f32x16 p0, p1; qkt<KB>(p0, p1, L, r32, hi, qr); \
            const int dq = trow - kb - 4 * hi;                         \
            const bool diag = kb + 63 > qlo; \
            bf16x8 pa0, pa1, pa2, pa3; \
            if (TYPE != 2) { \
                const float rf = (TYPE == 0) ? __builtin_amdgcn_exp2f((float)(trow - kb) * l2g) : __builtin_amdgcn_exp2f(rowA + BMX[t]); \
                if (diag) { _Pragma("unroll") for (int r = 0; r < 16; ++r) { const int c = (r & 3) + 8 * (r >> 2); p0[r] = (c <= dq) ? p0[r] * rf : 0.f; p1[r] = (c + 32 <= dq) ? p1[r] * rf : 0.f; } } \
                else { _Pragma("unroll") for (int r = 0; r < 16; ++r) { p0[r] *= rf; p1[r] *= rf; } } \
                if (TYPE == 1) { float ps = 0.f; _Pragma("unroll") for (int r = 0; r < 16; ++r) ps += p0[r] + p1[r]; den += ps; } \
            } else { \
                const int kblk = kb >> 8; const bool lane_ok = (kblk == own) || ((selmask >> kblk) & 1u); \
                const float NEG = -__builtin_inff(); \
                if (qlo - (kb + 63) < 128) { _Pragma("unroll") for (int r = 0; r < 16; ++r) { const int c = (r & 3) + 8 * (r >> 2); const int d0_ = dq - c, d1_ = dq - c - 32; \
                        const float x0 = fmaf(p0[r], C2, btab[d0_ < 0 ? 0 : (d0_ > 128 ? 128 : d0_)]), x1 = fmaf(p1[r], C2, btab[d1_ < 0 ? 0 : (d1_ > 128 ? 128 : d1_)]); \
                        p0[r] = (lane_ok && d0_ >= 0) ? x0 : NEG; p1[r] = (lane_ok && d1_ >= 0) ? x1 : NEG; if ((r & 3) == 3) asm volatile("" ::: "memory"); } } \
                else { _Pragma("unroll") for (int r = 0; r < 16; ++r) { p0[r] = lane_ok ? fmaf(p0[r], C2, b31) : NEG; p1[r] = lane_ok ? fmaf(p1[r], C2, b31) : NEG; } } \
                float pmax = p0[0]; _Pragma("unroll") for (int r = 1; r < 16; ++r) pmax = fmaxf(pmax, p0[r]); _Pragma("unroll") for (int r = 0; r < 16; ++r) pmax = fmaxf(pmax, p1[r]); \
                pmax = max_xor32(pmax); \
                float mn, alpha; \
                if (__all(pmax - m_reg <= THR)) { mn = m_reg; alpha = 1.f; } else { mn = fmaxf(m_reg, pmax); alpha = __builtin_amdgcn_exp2f(m_reg - mn); m_reg = mn; } \
                float ps = 0.f; _Pragma("unroll") for (int r = 0; r < 16; ++r) { p0[r] = __builtin_amdgcn_exp2f(p0[r] - mn); p1[r] = __builtin_amdgcn_exp2f(p1[r] - mn); ps += p0[r] + p1[r]; } \
                l_reg = l_reg * alpha + ps; \
                if (__any(alpha < 1.f)) { if (hi == 0) al_l[r32] = alpha; asm volatile("s_waitcnt lgkmcnt(0)" ::: "memory"); \
                    _Pragma("unroll") for (int r = 0; r < 16; ++r) { const float a_ = al_l[crow(r, hi)]; o[0][r] *= a_; o[1][r] *= a_; o[2][r] *= a_; o[3][r] *= a_; } } \
            } \
            MX_PK4(p0, 0, pa0); MX_PK4(p0, 8, pa1); MX_PK4(p1, 0, pa2); MX_PK4(p1, 8, pa3); \
            pv_tile<KB>(o, vb0, pa0, pa1, pa2, pa3); \
        } \
        if (t + 1 < NT) { VM_WAIT(); MX_WRITE((KB) ^ 1); } \
        __syncthreads(); } while (0)
#pragma unroll 1
    for (int tt = CH ? 2 * blk : 0; tt < NT; tt += 2) { MX_STEP(tt, 0); MX_STEP(tt + 1, 1); }
#undef MX_STEP
#undef MX_LOAD
#undef MX_WRITE
    float rs[16];
    if (TYPE == 2) {
        const float lt = sum_xor32(l_reg);
        if (hi == 0) li_l[r32] = 1.0f / lt; asm volatile("s_waitcnt lgkmcnt(0)" ::: "memory");
#pragma unroll
        for (int r = 0; r < 16; ++r) rs[r] = li_l[crow(r, hi)];
    } else {
        float pre[16];
        if (TYPE == 1) { const float dt = sum_xor32(den); const float nm = ((const float*)(p.ws + WS_NM))[grow * 4 + h];
            if (hi == 0) li_l[r32] = 1.0f / fmaxf(fabsf(dt), nm); asm volatile("s_waitcnt lgkmcnt(0)" ::: "memory");
#pragma unroll
            for (int r = 0; r < 16; ++r) pre[r] = li_l[crow(r, hi)]; }
        else {
#pragma unroll
            for (int r = 0; r < 16; ++r) pre[r] = 1.f; }
        float ss[16];
#pragma unroll
        for (int r = 0; r < 16; ++r) { const float a0 = o[0][r] * pre[r], a1 = o[1][r] * pre[r], a2 = o[2][r] * pre[r], a3 = o[3][r] * pre[r]; ss[r] = (a0 * a0 + a1 * a1) + (a2 * a2 + a3 * a3); }
#pragma unroll
        for (int r = 0; r < 16; ++r) { float v = ss[r]; v += swz_xor<1>(v); v += swz_xor<2>(v); v += swz_xor<4>(v); v += swz_xor<8>(v); v += swz_xor<16>(v); ss[r] = v; }
        if (TYPE == 1) {
            LAS float* ssx = (LAS float*)(L + X_OFF + X_SS);
            if (r32 == 0) {
#pragma unroll
                for (int r = 0; r < 16; ++r) ssx[wid * 32 + crow(r, hi)] = ss[r]; }
            __syncthreads();
#pragma unroll
            for (int r = 0; r < 16; ++r) ss[r] += ssx[(wid ^ 4) * 32 + crow(r, hi)];
        }
#pragma unroll
        for (int r = 0; r < 16; ++r) rs[r] = pre[r] / sqrtf(ss[r] * (1.f / HD) + EPS);
    }
    LAS unsigned short* stg = (LAS unsigned short*)(L + wid * 8192);
#pragma unroll
    for (int r = 0; r < 16; ++r) { const int q = crow(r, hi);
#pragma unroll
        for (int d0 = 0; d0 < 4; ++d0) stg[q * 128 + d0 * 32 + r32] = (unsigned short)f2bf(o[d0][r] * rs[r]); }
    asm volatile("s_waitcnt lgkmcnt(0)" ::: "memory");
    bf16* Y = (bf16*)(p.ws + WS_Y) + (size_t)TYPE * MG * 1024;
#pragma unroll
    for (int i = 0; i < 8; ++i) { const int rw = i * 4 + (lane >> 4), ch = lane & 15; const size_t gr = (size_t)b * SEQ + qlo + rw;
        const v4u v = *(const LAS v4u*)(stg + rw * 128 + ch * 8);
        const int col = h * HD + vhalf * 128 + ch * 8;
        if (TYPE == 2) { v2u o8; o8.x = pk4_fp8(bf_lo(v.x), bf_hi(v.x), bf_lo(v.y), bf_hi(v.y)); o8.y = pk4_fp8(bf_lo(v.z), bf_hi(v.z), bf_lo(v.w), bf_hi(v.w));
            *(GAS v2u*)((GAS unsigned char*)Y + gr * 1024 + col) = o8; }
        else { const v4u g = *(const GAS v4u*)(PROJ + gr * NPROJ + (TYPE == 0 ? C_RG : C_MO) + col);
            float e[8] = {bf_lo(v.x) * bf_lo(g.x), bf_hi(v.x) * bf_hi(g.x), bf_lo(v.y) * bf_lo(g.y), bf_hi(v.y) * bf_hi(g.y), bf_lo(v.z) * bf_lo(g.z), bf_hi(v.z) * bf_hi(g.z), bf_lo(v.w) * bf_lo(g.w), bf_hi(v.w) * bf_hi(g.w)};
            if (TYPE == 1) { const f32x4 n0 = *(const GAS f32x4*)(p.norm_w + col), n1 = *(const GAS f32x4*)(p.norm_w + col + 4);
                e[0] *= n0.x; e[1] *= n0.y; e[2] *= n0.z; e[3] *= n0.w; e[4] *= n1.x; e[5] *= n1.y; e[6] *= n1.z; e[7] *= n1.w; }
            v4u ow; ow.x = pk2(e[0], e[1]); ow.y = pk2(e[2], e[3]); ow.z = pk2(e[4], e[5]); ow.w = pk2(e[6], e[7]);
            *(GAS v4u*)(Y + gr * 1024 + col) = ow; }
    }
    __syncthreads();
}

__device__ __forceinline__ void mix_ret_chain(const MixArgs p, LAS unsigned char* L, int b, int h) {
    int tid0_ = threadIdx.x; asm volatile("" : "+v"(tid0_));
    const int wid = __builtin_amdgcn_readfirstlane(tid0_ >> 6);
    v4u st_k0, st_k1, st_v0, st_v1;
#define RC_LOAD(kb_) do { st_k0 = *(const GAS v4u*)(kg + (size_t)(kb_) * NPROJ); st_k1 = *(const GAS v4u*)(kg + (size_t)((kb_) + 32) * NPROJ); \
        st_v0 = *(const GAS v4u*)(vg + (size_t)(kb_) * NPROJ); st_v1 = *(const GAS v4u*)(vg + (size_t)((kb_) + 32) * NPROJ); } while (0)
#define RC_WRITE(bf) do { *(LAS v4u*)(L + K_OFF + (bf) * KBUF + kws) = st_k0; *(LAS v4u*)(L + K_OFF + (bf) * KBUF + kws + 32 * 256) = st_k1; \
        *(LAS v4u*)(L + V_OFF + (bf) * VBUF + vst0) = st_v0; *(LAS v4u*)(L + V_OFF + (bf) * VBUF + vst1) = st_v1; } while (0)
    const float l2g = log2_gamma(h), g64 = exp2f(64.f * l2g);
    const int ti = wid >> 1, tj = 2 * (wid & 1);
#define RC_TRRD(dst, base, off) asm volatile("ds_read_b64_tr_b16 %0, %1 offset:%2" : "=&v"(dst) : "v"(base), "i"(off) : "memory")
#define RC_STATE(KB) do { _Pragma("unroll") for (int ks = 0; ks < 4; ++ks) { s16x4 a0, a1, l0, h0, l1, h1; \
            RC_TRRD(a0, ka[0], (KB) * KBUF + ks * 4096); RC_TRRD(a1, ka[1], (KB) * KBUF + ks * 4096); \
            if (tj == 0) { RC_TRRD(l0, vb0, V_OFF + (KB) * VBUF + v_rd_off(0, 0, 0) + ks * 4096); RC_TRRD(h0, vb0, V_OFF + (KB) * VBUF + v_rd_off(0, 0, 0) + ks * 4096 + 2048); \
                           RC_TRRD(l1, vb0, V_OFF + (KB) * VBUF + v_rd_off(1, 0, 0) + ks * 4096); RC_TRRD(h1, vb0, V_OFF + (KB) * VBUF + v_rd_off(1, 0, 0) + ks * 4096 + 2048); } \
            else         { RC_TRRD(l0, vb0, V_OFF + (KB) * VBUF + v_rd_off(2, 0, 0) + ks * 4096); RC_TRRD(h0, vb0, V_OFF + (KB) * VBUF + v_rd_off(2, 0, 0) + ks * 4096 + 2048); \
                           RC_TRRD(l1, vb0, V_OFF + (KB) * VBUF + v_rd_off(3, 0, 0) + ks * 4096); RC_TRRD(h1, vb0, V_OFF + (KB) * VBUF + v_rd_off(3, 0, 0) + ks * 4096 + 2048); } \
            asm volatile("s_waitcnt lgkmcnt(0)" ::: "memory"); __builtin_amdgcn_sched_barrier(0); \
            const bf16x8 af = (bf16x8){a0[0], a0[1], a0[2], a0[3], a1[0], a1[1], a1[2], a1[3]}; \
            tt0 = __builtin_amdgcn_mfma_f32_32x32x16_bf16(af, (bf16x8){l0[0], l0[1], l0[2], l0[3], h0[0], h0[1], h0[2], h0[3]}, tt0, 0, 0, 0); \
            tt1 = __builtin_amdgcn_mfma_f32_32x32x16_bf16(af, (bf16x8){l1[0], l1[1], l1[2], l1[3], h1[0], h1[1], h1[2], h1[3]}, tt1, 0, 0, 0); } \
        _Pragma("unroll") for (int r = 0; r < 16; ++r) { tt0[r] *= g64; tt1[r] *= g64; } } while (0)
    f32x16 tt0 = {}, tt1 = {};
#pragma unroll 1
    for (int c = 0; c < 8; ++c) {
        int tid_ = tid0_; asm volatile("" : "+v"(tid_));
        const int tid = tid_, lane = tid & 63, r32 = lane & 31, hi = lane >> 5;
        const bf16* PROJ = (const bf16*)(p.ws + WS_PROJ);
        const bf16* Qp = PROJ + C_RQ + h * 128; const bf16* Kp = PROJ + C_RK + h * 128; const bf16* Vp = PROJ + C_RV + h * 128;
        const int sr = tid >> 4, sc = (tid & 15) * 8, kws = KSWZ(sr, sc * 2), vst0 = v_st(sr, sc), vst1 = v_st(32 + sr, sc);
        const bf16* kg = Kp + ((size_t)b * SEQ + sr) * NPROJ + sc; const bf16* vg = Vp + ((size_t)b * SEQ + sr) * NPROJ + sc;
        LAS float* al_l = (LAS float*)(L + X_OFF + X_AL) + wid * 32;
        const int vb0 = (int)(unsigned)(size_t)L + v_rd_base(lane), vbT = vb0 + 16384;
        int ka[2];
#pragma unroll
        for (int u = 0; u < 2; ++u) { const int q = lane & 15, G = lane >> 4, row = 8 * (G >> 1) + 4 * u + (q >> 2), colB = 2 * (32 * ti + 16 * (G & 1) + 4 * (q & 3));
            ka[u] = (int)(unsigned)(size_t)(L + K_OFF) + KSWZ(row, colB); }
        const int P0 = c * 256, qlo = P0 + 32 * wid, trow = qlo + r32;
        const size_t grow = (size_t)b * SEQ + trow;
        bf16x8 qr[8];
#pragma unroll
        for (int d0 = 0; d0 < 8; ++d0) qr[d0] = *(const GAS bf16x8*)(Qp + grow * NPROJ + d0 * 16 + hi * 8);
        RC_LOAD(P0);
        f32x16 o[4] = {};
        if (c > 0) {
            if (hi == 0) al_l[r32] = __builtin_amdgcn_exp2f((float)(32 * wid + r32) * l2g);
            pv_tile<0>(o, vbT, qr[0], qr[1], qr[2], qr[3]);
            pv_tile<1>(o, vbT, qr[4], qr[5], qr[6], qr[7]);
            asm volatile("s_waitcnt lgkmcnt(0)" ::: "memory");
#pragma unroll
            for (int r = 0; r < 16; ++r) { const float a_ = al_l[crow(r, hi)]; o[0][r] *= a_; o[1][r] *= a_; o[2][r] *= a_; o[3][r] *= a_; }
        }
        VM_WAIT(); RC_WRITE(0);
        __syncthreads();
#define RC_STEP(j_, KB) do { const int kb = P0 + 64 * (j_); \
        if ((j_) < 3) RC_LOAD(kb + 64); \
        if (kb <= qlo + 31) { \
            f32x16 p0, p1; qkt<KB>(p0, p1, L, r32, hi, qr); \
            const int dq = trow - kb - 4 * hi; \
            const bool diag = kb + 63 > qlo; \
            bf16x8 pa0, pa1, pa2, pa3; \
            const float rf = __builtin_amdgcn_exp2f((float)(trow - kb) * l2g); \
            if (diag) { _Pragma("unroll") for (int r = 0; r < 16; ++r) { const int cc = (r & 3) + 8 * (r >> 2); p0[r] = (cc <= dq) ? p0[r] * rf : 0.f; p1[r] = (cc + 32 <= dq) ? p1[r] * rf : 0.f; } } \
            else { _Pragma("unroll") for (int r = 0; r < 16; ++r) { p0[r] *= rf; p1[r] *= rf; } } \
            MX_PK4(p0, 0, pa0); MX_PK4(p0, 8, pa1); MX_PK4(p1, 0, pa2); MX_PK4(p1, 8, pa3); \
            pv_tile<KB>(o, vb0, pa0, pa1, pa2, pa3); \
        } \
        if (c < 7) RC_STATE(KB); \
        if ((j_) < 3) { VM_WAIT(); RC_WRITE((KB) ^ 1); } \
        __syncthreads(); } while (0)
        RC_STEP(0, 0); RC_STEP(1, 1); RC_STEP(2, 0); RC_STEP(3, 1);
#undef RC_STEP
        float rs[16];
        { float ss[16];
#pragma unroll
          for (int r = 0; r < 16; ++r) { const float a0 = o[0][r], a1 = o[1][r], a2 = o[2][r], a3 = o[3][r]; ss[r] = (a0 * a0 + a1 * a1) + (a2 * a2 + a3 * a3); }
#pragma unroll
          for (int r = 0; r < 16; ++r) { float v = ss[r]; v += swz_xor<1>(v); v += swz_xor<2>(v); v += swz_xor<4>(v); v += swz_xor<8>(v); v += swz_xor<16>(v); ss[r] = v; }
#pragma unroll
          for (int r = 0; r < 16; ++r) rs[r] = 1.0f / sqrtf(ss[r] * (1.f / 128.f) + EPS); }
        LAS unsigned short* stg = (LAS unsigned short*)(L + wid * 8192);
#pragma unroll
        for (int r = 0; r < 16; ++r) { const int q = crow(r, hi);
#pragma unroll
            for (int d0 = 0; d0 < 4; ++d0) stg[q * 128 + d0 * 32 + r32] = (unsigned short)f2bf(o[d0][r] * rs[r]); }
        asm volatile("s_waitcnt lgkmcnt(0)" ::: "memory");
        bf16* Y = (bf16*)(p.ws + WS_Y);
#pragma unroll
        for (int i = 0; i < 8; ++i) { const int rw = i * 4 + (lane >> 4), ch = lane & 15; const size_t gr = (size_t)b * SEQ + qlo + rw;
            const v4u v = *(const LAS v4u*)(stg + rw * 128 + ch * 8);
            const int col = h * 128 + ch * 8;
            const v4u g = *(const GAS v4u*)(PROJ + gr * NPROJ + C_RG + col);
            float e[8] = {bf_lo(v.x) * bf_lo(g.x), bf_hi(v.x) * bf_hi(g.x), bf_lo(v.y) * bf_lo(g.y), bf_hi(v.y) * bf_hi(g.y), bf_lo(v.z) * bf_lo(g.z), bf_hi(v.z) * bf_hi(g.z), bf_lo(v.w) * bf_lo(g.w), bf_hi(v.w) * bf_hi(g.w)};
            v4u ow; ow.x = pk2(e[0], e[1]); ow.y = pk2(e[2], e[3]); ow.z = pk2(e[4], e[5]); ow.w = pk2(e[6], e[7]);
            *(GAS v4u*)(Y + gr * 1024 + col) = ow; }
        __syncthreads();
        if (c < 7) {
#pragma unroll
            for (int r = 0; r < 16; ++r) { const int d = 32 * ti + crow(r, hi);
                LAS unsigned char* tb = L + V_OFF + (d >> 6) * VBUF + 16384;
                *(LAS unsigned short*)(tb + v_st(d & 63, 32 * tj + r32)) = (unsigned short)f2bf(tt0[r]);
                *(LAS unsigned short*)(tb + v_st(d & 63, 32 * (tj + 1) + r32)) = (unsigned short)f2bf(tt1[r]); }
            __syncthreads();
        }
    }
#undef RC_LOAD
#undef RC_WRITE
#undef RC_TRRD
#undef RC_STATE
}

__device__ __forceinline__ s16x4 scale4(s16x4 x, float s) {
    const v2u w = __builtin_bit_cast(v2u, x);
    v2u o; o.x = cvtpk(bf_lo(w.x) * s, bf_hi(w.x) * s); o.y = cvtpk(bf_lo(w.y) * s, bf_hi(w.y) * s);
    return __builtin_bit_cast(s16x4, o);
}
__device__ __forceinline__ void mlstm_state_job(const MixArgs p, LAS unsigned char* L, int b, int h, unsigned* ctr) {
    int tid0_ = threadIdx.x; asm volatile("" : "+v"(tid0_));
    const int wid = __builtin_amdgcn_readfirstlane(tid0_ >> 6);
    const int ti = wid >> 1, vh = wid & 1;
    f32x16 t0 = {}, t1 = {}, t2 = {}, t3 = {}, zz = {};
    float R = -__builtin_inff();
    const float* BMX = (const float*)(p.ws + WS_BMAX) + (b * 4 + h) * 32;
    v4u st_k0, st_k1, st_v0, st_v1, st_v2, st_v3;
#define SJ_TRRD(dst, base, off) asm volatile("ds_read_b64_tr_b16 %0, %1 offset:%2" : "=&v"(dst) : "v"(base), "i"(off) : "memory")
#define SJ_LOAD(kb_) do { st_k0 = *(const GAS v4u*)(kg + (size_t)(kb_) * 1024); st_k1 = *(const GAS v4u*)(kg + (size_t)((kb_) + 32) * 1024); \
        st_v0 = *(const GAS v4u*)(vg + (size_t)(kb_) * NPROJ); st_v1 = *(const GAS v4u*)(vg + (size_t)((kb_) + 32) * NPROJ); \
        st_v2 = *(const GAS v4u*)(vg + (size_t)(kb_) * NPROJ + 128); st_v3 = *(const GAS v4u*)(vg + (size_t)((kb_) + 32) * NPROJ + 128); } while (0)
#define SJ_WRITE(bf) do { *(LAS v4u*)(L + K_OFF + (bf) * KBUF + kws) = st_k0; *(LAS v4u*)(L + K_OFF + (bf) * KBUF + kws + 32 * 256) = st_k1; \
        *(LAS v4u*)(L + V_OFF + (bf) * VBUF + vst0) = st_v0; *(LAS v4u*)(L + V_OFF + (bf) * VBUF + vst1) = st_v1; \
        *(LAS v4u*)(L + V_OFF + (bf) * VBUF + 16384 + vst0) = st_v2; *(LAS v4u*)(L + V_OFF + (bf) * VBUF + 16384 + vst1) = st_v3; } while (0)
#define SJ_VF(d0_, KB, ks_) (bf16x8){l##d0_[0], l##d0_[1], l##d0_[2], l##d0_[3], g##d0_[0], g##d0_[1], g##d0_[2], g##d0_[3]}
#define SJ_TILE(KB, bt_) do { const float bt = (bt_); _Pragma("unroll") for (int ks = 0; ks < 4; ++ks) { s16x4 a0, a1, l0, g0, l1, g1, l2, g2, l3, g3; \
            SJ_TRRD(a0, ka[0], (KB) * KBUF + ks * 4096); SJ_TRRD(a1, ka[1], (KB) * KBUF + ks * 4096); \
            SJ_TRRD(l0, vbh, V_OFF + (KB) * VBUF + 0 * 512 + ks * 4096); SJ_TRRD(g0, vbh, V_OFF + (KB) * VBUF + 0 * 512 + ks * 4096 + 2048); \
            SJ_TRRD(l1, vbh, V_OFF + (KB) * VBUF + 1 * 512 + ks * 4096); SJ_TRRD(g1, vbh, V_OFF + (KB) * VBUF + 1 * 512 + ks * 4096 + 2048); \
            SJ_TRRD(l2, vbh, V_OFF + (KB) * VBUF + 2 * 512 + ks * 4096); SJ_TRRD(g2, vbh, V_OFF + (KB) * VBUF + 2 * 512 + ks * 4096 + 2048); \
            SJ_TRRD(l3, vbh, V_OFF + (KB) * VBUF + 3 * 512 + ks * 4096); SJ_TRRD(g3, vbh, V_OFF + (KB) * VBUF + 3 * 512 + ks * 4096 + 2048); \
            asm volatile("s_waitcnt lgkmcnt(0)" ::: "memory"); __builtin_amdgcn_sched_barrier(0); \
            a0 = scale4(a0, bt); a1 = scale4(a1, bt); \
            const bf16x8 af = (bf16x8){a0[0], a0[1], a0[2], a0[3], a1[0], a1[1], a1[2], a1[3]}; \
            t0 = __builtin_amdgcn_mfma_f32_32x32x16_bf16(af, SJ_VF(0, KB, ks), t0, 0, 0, 0); \
            t1 = __builtin_amdgcn_mfma_f32_32x32x16_bf16(af, SJ_VF(1, KB, ks), t1, 0, 0, 0); \
            t2 = __builtin_amdgcn_mfma_f32_32x32x16_bf16(af, SJ_VF(2, KB, ks), t2, 0, 0, 0); \
            t3 = __builtin_amdgcn_mfma_f32_32x32x16_bf16(af, SJ_VF(3, KB, ks), t3, 0, 0, 0); \
            if (vh == 0) zz = __builtin_amdgcn_mfma_f32_32x32x16_bf16(af, ones, zz, 0, 0, 0); } } while (0)
#pragma unroll 1
    for (int c = 0; c < 15; ++c) {
        int tid_ = tid0_; asm volatile("" : "+v"(tid_));
        const int tid = tid_, lane = tid & 63, r32 = lane & 31, hi = lane >> 5;
        const bf16* MQK = (const bf16*)(p.ws + WS_MQK); const bf16* PROJ = (const bf16*)(p.ws + WS_PROJ);
        const int sr = tid >> 4, sc = (tid & 15) * 8, kws = KSWZ(sr, sc * 2), vst0 = v_st(sr, sc), vst1 = v_st(32 + sr, sc);
        const bf16* kg = MQK + 512 + h * 128 + ((size_t)b * SEQ + sr) * 1024 + sc; const bf16* vg = PROJ + C_MV + h * 256 + ((size_t)b * SEQ + sr) * NPROJ + sc;
        const int vbh = (int)(unsigned)(size_t)(L + vh * 16384) + v_rd_base(lane);
        int ka[2];
#pragma unroll
        for (int u = 0; u < 2; ++u) { const int q = lane & 15, G = lane >> 4, row = 8 * (G >> 1) + 4 * u + (q >> 2), colB = 2 * (32 * ti + 16 * (G & 1) + 4 * (q & 3));
            ka[u] = (int)(unsigned)(size_t)(L + K_OFF) + KSWZ(row, colB); }
        const bf16x8 ones = (bf16x8){0x3F80, 0x3F80, 0x3F80, 0x3F80, 0x3F80, 0x3F80, 0x3F80, 0x3F80};
        SJ_LOAD(128 * c);
        VM_WAIT(); SJ_WRITE(0);
        SJ_LOAD(128 * c + 64);
        __syncthreads();
#pragma unroll
        for (int half = 0; half < 2; ++half) {
            const float bm = BMX[2 * c + half];
            const float Rn = fmaxf(R, bm);
            if (Rn != R) { const float a_ = __builtin_amdgcn_exp2f(R - Rn);
#pragma unroll
                for (int r = 0; r < 16; ++r) { t0[r] *= a_; t1[r] *= a_; t2[r] *= a_; t3[r] *= a_; zz[r] *= a_; } }
            R = Rn;
            if (half == 0) { SJ_TILE(0, __builtin_amdgcn_exp2f(bm - Rn)); VM_WAIT(); SJ_WRITE(1); __syncthreads(); }
            else { SJ_TILE(1, __builtin_amdgcn_exp2f(bm - Rn)); }
        }
        { bf16* img = (bf16*)(p.ws + WS_MST_IMG) + (size_t)(h * 16 + c + 1) * 128 * 256;
#pragma unroll
          for (int r = 0; r < 16; ++r) { const int d = 32 * ti + crow(r, hi); GAS unsigned short* row = (GAS unsigned short*)img + (size_t)d * 256 + 128 * vh + r32;
              row[0] = (unsigned short)f2bf(t0[r]); row[32] = (unsigned short)f2bf(t1[r]); row[64] = (unsigned short)f2bf(t2[r]); row[96] = (unsigned short)f2bf(t3[r]); }
          if (vh == 0 && r32 == 0) { GAS float* zb = (GAS float*)(p.ws + WS_MST_Z) + (h * 16 + c + 1) * 128 + 32 * ti;
#pragma unroll
              for (int r = 0; r < 16; ++r) zb[crow(r, hi)] = zz[r]; }
          if (tid == 0) ((GAS float*)(p.ws + WS_MST_R))[h * 16 + c + 1] = R; }
        asm volatile("s_waitcnt vmcnt(0)" ::: "memory");
        __syncthreads();
        if (tid == 0) { __builtin_amdgcn_fence(__ATOMIC_RELEASE, "agent"); asm volatile("s_waitcnt vmcnt(0)" ::: "memory");
            __hip_atomic_store(ctr, (unsigned)(c + 1), __ATOMIC_RELAXED, __HIP_MEMORY_SCOPE_AGENT); }
    }
#undef SJ_TRRD
#undef SJ_LOAD
#undef SJ_WRITE
#undef SJ_VF
#undef SJ_TILE
}
#undef KSWZ
#undef MX_PK4
}

__device__ __forceinline__ void phase_mix_mfma(const Frame& F0, KArgs a, int layer, int it) { Frame F = relocal(F0);
    constexpr int NSJ = GB * 4, NCH = GB * 8, NMB = GB * 64, NML = GB * 64, NTASK = NSJ + NCH + NMB + NML;
    static_assert(GB == 1, "task decode");
    unsigned* ctr0 = (unsigned*)(F.ctl + CW_Q2 + 64 * (it + NIT * F.team)) + 1;
    volatile LAS unsigned* slot = F.MISC + 16;
    mx::MixArgs ma; ma.ws = F.ws; ma.rel_bias = a->in[14]; ma.norm_w = a->in[5] + (size_t)layer * 1024;
    LAS unsigned char* L = F.lds + RING_OFF;
    for (;;) {
        __syncthreads();
        if (F.tid == 0) slot[0] = __hip_atomic_fetch_add((unsigned*)(F.ctl + CW_Q2 + 64 * (it + NIT * F.team)), 1u, RLX_AGENT);
        __syncthreads();
        const int task = (int)slot[0];
        if (task >= NTASK) break;
        if (task < NSJ) { mx::mlstm_state_job(ma, L, 0, task, ctr0 + task); continue; }
        if (task < NSJ + NCH) { mx::mix_ret_chain(ma, L, 0, task - NSJ); continue; }
        if (task < NSJ + NCH + NMB) { const int r = task - NSJ - NCH; mx::mix_block<2>(ma, L, 0, r & 7, 7 - (r >> 3)); continue; }
        { const int r = task - NSJ - NCH - NMB; mx::mix_block<1, true>(ma, L, 0, r & 3, r >> 2, ctr0 + (r & 3)); }
    }
    __syncthreads();
}

__global__ void __launch_bounds__(NWAVES * 64, 2) hybrid_fwd(Args args) {
    extern __shared__ __attribute__((aligned(16))) unsigned char lds[];
    Frame F;
    F.lds = (LAS unsigned char*)lds;
    F.MISC = (volatile LAS unsigned*)(F.lds + MISC_OFF);
    F.tid = threadIdx.x; F.lane = F.tid & 63; F.wave = __builtin_amdgcn_readfirstlane(F.tid >> 6);
    const int bx = blockIdx.x, gall = gridDim.x;
    F.team = (bx & 7) / XPT; F.bidx = (bx >> 3) * XPT + (bx & 7) % XPT; F.G = gall / NTEAM;
    F.vcu = ((bx & 7) % XPT) * (F.G / XPT) + (bx >> 3);
    F.wsw = args.ws; F.ws = args.ws + WS_ACT + (size_t)F.team * TEAM_STRIDE; F.out = args.out;
    F.ctl = (gu32*)(args.ws + WS_CTL);
    for (int u = F.tid; u < (LDS_BYTES - LDSCTL_OFF) / 4; u += NWAVES * 64) ((LAS unsigned*)(F.lds + LDSCTL_OFF))[u] = 0u;
    __syncthreads();
    XcdBarrier barG = xcd_barrier_post((unsigned*)(F.ctl + CW_BAR), F.MISC + 8, (unsigned)gall);
    XcdBarrier bar = xcd_barrier_post((unsigned*)(F.ctl + CW_BAR) + (1 + F.team) * XCD_BAR_WORDS, F.MISC + 10, (unsigned)F.G);
    static_assert((CW_BAR + (1 + NTEAM) * XCD_BAR_WORDS) * 4 <= (int)CTL_ZERO_BYTES && CW_Q2 + 64 * NIT * NTEAM <= CW_BAR, "control words");
#define SEAM() xcd_barrier(bar)

    phase_prologue(F, kargs(), 0, PRO_PER_L, bx, gall, true);
    xcd_barrier(barG);
    { const int t = F.team;
        const int i0 = PRO_PER_L + (int)((long)PRO_PER_L * t / NTEAM), i1 = PRO_PER_L + (int)((long)PRO_PER_L * (t + 1) / NTEAM);
        phase_prologue(F, kargs(), i0, i1, F.bidx, F.G, false); SEAM();
        if (F.bidx == 0 && F.tid == 0) __hip_atomic_fetch_add((unsigned*)(F.ctl + CW_FLAG), 1u, RLX_AGENT); }

#pragma unroll 1
    for (int it = 0; it < NIT; ++it) {
        const int layer = it / GPT, grp = F.team * GPT + it % GPT;
        if (it == GPT) {
            if (F.tid == 0) { unsigned sp = 0; while (__hip_atomic_load((unsigned*)(F.ctl + CW_FLAG), RLX_AGENT) < (unsigned)NTEAM) { __builtin_amdgcn_s_sleep(8); if (++sp > (1u << 22)) break; }
                __builtin_amdgcn_fence(__ATOMIC_ACQUIRE, "agent"); asm volatile("s_waitcnt vmcnt(0)" ::: "memory"); }
            __syncthreads();
        }
        const size_t grow0 = (size_t)grp * MG;
        const float* xin = (layer == 0 ? kargs()->in[0] : (const float*)F.out) + grow0 * DM;
        float* xout = F.out + grow0 * DM;
        bf16* HB = (bf16*)(opq(F.ws) + WS_HB); bf16* PROJ = (bf16*)(opq(F.ws) + WS_PROJ); bf16* MIXED = (bf16*)(opq(F.ws) + WS_MIXED); bf16* UB = (bf16*)(opq(F.ws) + WS_PROJ);

        if (layer == 0) phase_norm1<false>(F, kargs(), layer, xin); else phase_norm1<true>(F, kargs(), layer, xin);
        SEAM();

        {
            { pg8::Gemm g{HB, (const bf16*)(opq(F.wsw) + WS_WIN + layer * SZ_WIN), DM, 0, 0}; pg8::StaticOrder S; S.init(MG, NP16, F.G, F.bidx);
              pg8::EpiProj<true> E{PROJ, NPROJ, 0};
              pg8::gemm_phase<pg8::EpiProj<true>, pg8::StaticOrder, true, true, false>(F.lds + RING_OFF, g, S, E); }
            { pg8::Gemm g{(const bf16*)(opq(F.ws) + WS_HB8), (const bf16*)(opq(F.wsw) + WS_WIN8 + layer * SZ_WIN8), DM / 2, 0, 0}; pg8::StaticOrder S; S.init(MG, NP8, F.G, F.bidx);
              pg8::EpiProj<false> E{PROJ, NPROJ, NP16 / 256};
              pg8::gemm_phase<pg8::EpiProj<false>, pg8::StaticOrder, true, true, true>(F.lds + RING_OFF, g, S, E); }
            for (int bh = F.bidx; bh < GB * 4; bh += F.G) gate_scan(F, bh);
            SEAM();
        }

        phase_prep(F, kargs(), layer); SEAM();

        phase_mix_mfma(F, kargs(), layer, it); SEAM();

        {
            pg8::Gemm g{(const bf16*)(opq(F.ws) + WS_Y), (const bf16*)(opq(F.wsw) + WS_WBR + layer * SZ_WBR), 1024, (size_t)MG * 1024 * 2, (size_t)DM * 1024 * 2};
            { pg8::Gemm g8{(const bf16*)(opq(F.ws) + WS_Y + (size_t)2 * MG * 1024 * 2), (const bf16*)(opq(F.wsw) + WS_WBR8 + layer * SZ_WBR8), 512, 0, 0};
              pg8::StaticOrder S; S.init(MG, DM, F.G, F.bidx);
              pg8::EpiBranch E{MIXED, DM, PROJ + C_GATE, NPROJ, DM, 2};
              pg8::gemm_phase<pg8::EpiBranch, pg8::StaticOrder, true, true, true>(F.lds + RING_OFF, g8, S, E); }
            { pg8::PairOrder S; S.init(MG, DM, F.G, F.bidx);
              pg8::EpiBranch E{MIXED, DM, PROJ + C_GATE, NPROJ, DM, -1};
              pg8::gemm_phase<pg8::EpiBranch, pg8::PairOrder, true, true>(F.lds + RING_OFF, g, S, E); }
            SEAM();
        }

        {
            pg8::Gemm g{MIXED, (const bf16*)(opq(F.wsw) + WS_WOUT + layer * SZ_WOUT), DM, 0, 0}; pg8::RevOrder S; S.init(MG, DM, F.G, F.bidx);
            bf16* HRAW = (bf16*)(opq(F.ws) + WS_HRAW); float* SSP = (float*)(opq(F.ws) + WS_SSP); const float* gain2 = kargs()->in[11] + (size_t)layer * DM;
            if (layer == 0) { pg8::EpiResB<true, true> E{xin, (bf16*)xout, DM, 2 * DM, HRAW, gain2, SSP, DM}; pg8::gemm_phase<pg8::EpiResB<true, true>, pg8::RevOrder, true, true>(F.lds + RING_OFF, g, S, E); }
            else { pg8::EpiResB<false, true> E{xout, (bf16*)xout, 2 * DM, 2 * DM, HRAW, gain2, SSP, DM}; pg8::gemm_phase<pg8::EpiResB<false, true>, pg8::RevOrder, true, true>(F.lds + RING_OFF, g, S, E); }
            SEAM();
        }

        {
            { Frame Fl = relocal(F); LAS float* rt = (LAS float*)(Fl.lds + RSTD_OFF); const float* ssp = (const float*)(opq(Fl.ws) + WS_SSP);
              for (int r = Fl.tid; r < MG; r += NWAVES * 64) { const GAS f32x4* p = (const GAS f32x4*)(ssp + (size_t)r * 32); f32x4 s4 = p[0];
#pragma unroll
                  for (int j = 1; j < 8; ++j) s4 += p[j];
                  rt[r] = 1.0f / sqrtf(((s4.x + s4.y) + (s4.z + s4.w)) * (1.f / DM) + EPS); }
              __syncthreads(); }
            pg8::Gemm g{(const bf16*)xout, (const bf16*)(opq(F.wsw) + WS_WFF1 + layer * SZ_WFF), DM, 0, 0, 2 * DM};     pg8::StaticOrder S; S.init(MG, DFF, F.G, F.bidx);
            pg8::EpiRelu2 E{UB, DFF, (const LAS float*)(F.lds + RSTD_OFF)};
            pg8::gemm_phase<pg8::EpiRelu2, pg8::StaticOrder, true, true>(F.lds + RING_OFF, g, S, E);
            SEAM();
        }

        {
            pg8::Gemm g{UB, (const bf16*)(opq(F.wsw) + WS_WFF2 + layer * SZ_WFF), DFF, 0, 0}; pg8::RevOrder S; S.init(MG, DM, F.G, F.bidx);
            pg8::EpiResB<false> E{xout, (bf16*)xout, 2 * DM, 2 * DM, nullptr, nullptr, nullptr, 0};
            pg8::gemm_phase<pg8::EpiResB<false>, pg8::RevOrder, true, true>(F.lds + RING_OFF, g, S, E);
            if (it == NIT - 1) SEAM();
        }
    }

    phase_final(F, kargs());
#undef SEAM
}

extern "C" void kernel_launch(void* const* d_in, const int* in_sizes, int n_in, void* d_out, int out_size, void* d_ws, size_t ws_size, hipStream_t stream) {
    static int grid = 0;
    if (grid == 0) {
        if (n_in != 16 || in_sizes[0] != BATCH * SEQ * DM || out_size != BATCH * SEQ * DM || ws_size < WS_END) {
            fprintf(stderr, "kernel_launch: shape/workspace mismatch (n_in %d, in0 %d, out %d, ws %zu, need %zu)\n", n_in, n_in > 0 ? in_sizes[0] : -1, out_size, ws_size, (size_t)WS_END); grid = -1; return; }
        int dev = 0, cus = 0, per_cu = 0;
        if (hipGetDevice(&dev) != hipSuccess || hipDeviceGetAttribute(&cus, hipDeviceAttributeMultiprocessorCount, dev) != hipSuccess) { grid = -1; return; }
        if (hipFuncSetAttribute((const void*)hybrid_fwd, hipFuncAttributeMaxDynamicSharedMemorySize, LDS_BYTES) != hipSuccess) { fprintf(stderr, "kernel_launch: hipFuncSetAttribute failed\n"); grid = -1; return; }
        if (hipOccupancyMaxActiveBlocksPerMultiprocessor(&per_cu, (const void*)hybrid_fwd, NWAVES * 64, LDS_BYTES) != hipSuccess || per_cu < 1)
            fprintf(stderr, "kernel_launch: note: occupancy query reports %d workgroups per CU\n", per_cu);
        (void)hipGetLastError();
        grid = cus;
        if (grid % (8 * NTEAM) != 0 && grid % 16 != 0) { fprintf(stderr, "kernel_launch: %d CUs: the two-team split needs a multiple of 16\n", grid); grid = -1; return; }
    }
    if (grid < 0) return;
    if (hipMemsetAsync((char*)d_ws + WS_CTL, 0, CTL_ZERO_BYTES, stream) != hipSuccess) return;
    Args a{};
    for (int i = 0; i < 16; ++i) a.in[i] = (const float*)d_in[i];
    a.out = (float*)d_out; a.ws = (unsigned char*)d_ws;
    hipLaunchKernelGGL(hybrid_fwd, dim3(grid), dim3(NWAVES * 64), LDS_BYTES, stream, a);
}
```

```cpp
#include <hip/hip_runtime.h>
#include <cstdio>
#include <cstdint>

#ifndef MK_NTEAM
#define MK_NTEAM 8
#endif

namespace pg8 {
#define PG8_LAS __attribute__((address_space(3)))
#define PG8_GAS __attribute__((address_space(1)))
typedef unsigned short bf16_t;
typedef short bf16x8 __attribute__((ext_vector_type(8)));
typedef float f32x4 __attribute__((ext_vector_type(4)));
typedef unsigned u32x4 __attribute__((ext_vector_type(4)));
typedef unsigned u32x2 __attribute__((ext_vector_type(2)));
typedef int v4i32 __attribute__((ext_vector_type(4)));
typedef int v8i32 __attribute__((ext_vector_type(8)));
constexpr int BM = 256, BK = 64, HALF = 128, HTB = HALF * BK * 2, STAGE_BYTES = 8 * HTB, NXCD = 8 / MK_NTEAM, WGM = 4;

__host__ __device__ __forceinline__ int lds_byte(int r, int c) { const int st = (r >> 4) * 2 + (c >> 5), rr = r & 15, cc = c & 31, ob = rr * 64 + cc * 2; return st * 1024 + (ob ^ (((ob >> 9) & 1) << 5)); }
__host__ __device__ __forceinline__ void stage_rc(int b, int& R, int& C) { const int st = b / 1024, sb = b % 1024, swz = sb ^ (((sb >> 9) & 1) << 5); R = (st >> 1) * 16 + swz / 64; C = (st & 1) * 32 + (swz % 64) / 2; }
__host__ __device__ __forceinline__ int perm32(int rho) { const int n = rho >> 4, i = rho & 15; return 8 * (i >> 2) + 4 * n + (i & 3); }

struct Unit { int pm, pn, sub; };
struct Gemm { const bf16_t* A; const bf16_t* Bt; int K; size_t subA, subB; int lda; };

struct StaticOrder {
    int nM, nN, nwg, G, c;
    __host__ __device__ void init(int M, int N, int G_, int c_) { nM = M / BM; nN = N / BM; nwg = nM * nN; G = G_; c = c_; }
    __host__ __device__ bool tile(long L, Unit& u) const {
        if (L >= nwg) return false;
        int wgid = (int)L; { const int q = nwg / NXCD, r = nwg % NXCD, xcd = wgid % NXCD, off = wgid / NXCD; wgid = (xcd < r ? xcd * (q + 1) : r * (q + 1) + (xcd - r) * q) + off; }
        const int nig = WGM * nN, gid = wgid / nig, fm = gid * WGM, gsz = (nM - fm) < WGM ? (nM - fm) : WGM;
        u.pm = fm + ((wgid % nig) % gsz); u.pn = (wgid % nig) / gsz; u.sub = 0; return true;
    }
    __host__ __device__ bool next(int i, Unit& u) const { return tile((long)i * G + c, u); }
    __device__ __forceinline__ void a_ready(const Unit&) const {}
    __device__ __forceinline__ void done(const Unit&) const {}
};
struct PairOrder : StaticOrder {
    __host__ __device__ bool next(int i, Unit& u) const { const int j = i >> 1; if (!tile((long)j * G + c, u)) return false; u.sub = i & 1; return true; }
};
struct RevOrder : StaticOrder {
    __host__ __device__ bool next(int i, Unit& u) const { if (!tile((long)i * G + c, u)) return false; u.pm = nM - 1 - u.pm; return true; }
};
struct TripleOrder : StaticOrder {
    __host__ __device__ bool next(int i, Unit& u) const { const int j = i / 3; if (!tile((long)j * G + c, u)) return false; u.sub = i - 3 * j; return true; }
};

__device__ __forceinline__ unsigned cvt_pk_bf16(float lo, float hi) { unsigned r; asm volatile("v_cvt_pk_bf16_f32 %0, %1, %2" : "=v"(r) : "v"(lo), "v"(hi)); return r; }
__device__ __forceinline__ float sigmoidf_fast(float x) { return __builtin_amdgcn_rcpf(1.0f + __builtin_amdgcn_exp2f(-1.4426950408889634f * x)); }
__device__ __forceinline__ float bf_lo(unsigned u) { return __uint_as_float(u << 16); }
__device__ __forceinline__ float bf_hi(unsigned u) { return __uint_as_float(u & 0xffff0000u); }


__device__ __forceinline__ float epi_log2_gamma(int h) { const float x = __builtin_amdgcn_exp2f(-5.0f - (float)h); const float x2 = x * x;
    return -(x + x2 * (0.5f + x * (1.f / 3.f) + x2 * (0.25f + x * 0.2f + x2 * (1.f / 6.f)))) * 1.4426950408889634f; }
template <bool ROT>
struct EpiProj {
    static constexpr bool PERM = true; static constexpr bool CHAIN = false;
    bf16_t* O; int ldc; int pn_off;
    __device__ __forceinline__ void operator()(const f32x4 (&acc)[2][2][4][2], const Unit& u, int wr, int wc, int fr, int fq) const {
        const int ct = u.pn + pn_off; int act = 0;
        const int row0 = u.pm * BM + wr * 64 + fr, col0 = ct * BM + wc * 32 + 8 * fq;
        if (ct >= 12 && ct < 16) act = 1; else if ((ct >= 24 && ct < 28) || ct >= 40) act = 2;
        if (ROT && ct < 8) {
            const float inv0 = __builtin_amdgcn_exp2f(-(float)(16 * wc + 4 * fq) * (13.287712379549449f / 64.f)) * 0.15915494309189535f;
            constexpr float RS[4] = {1.0f, 0.8659643233600653f, 0.7498942093324559f, 0.6493816315762113f};
            const float l2g0 = epi_log2_gamma(((ct & 3) << 1)), l2g1 = epi_log2_gamma(((ct & 3) << 1) + 1);
#pragma unroll
            for (int ai = 0; ai < 2; ++ai)
#pragma unroll
                for (int m = 0; m < 4; ++m) { const int row = row0 + ai * HALF + m * 16; const int t = row & 2047; bf16_t* rowp = O + (size_t)row * ldc + col0;
                    const float sc0 = (ct < 4) ? 0.08838834764831845f : __builtin_amdgcn_exp2f(-(float)(t & 63) * l2g0), sc1 = (ct < 4) ? 0.08838834764831845f : __builtin_amdgcn_exp2f(-(float)(t & 63) * l2g1);
                    u32x4 w0, w1;
#pragma unroll
                    for (int e = 0; e < 4; ++e) { const float fr_ = __builtin_amdgcn_fractf((float)t * (inv0 * RS[e])); const float c_ = __builtin_amdgcn_cosf(fr_), s_ = __builtin_amdgcn_sinf(fr_);
                        const float a0 = acc[ai][0][m][e >> 1][(e & 1) * 2], b0 = acc[ai][0][m][e >> 1][(e & 1) * 2 + 1], a1 = acc[ai][1][m][e >> 1][(e & 1) * 2], b1 = acc[ai][1][m][e >> 1][(e & 1) * 2 + 1];
                        w0[e] = cvt_pk_bf16((a0 * c_ - b0 * s_) * sc0, (a0 * s_ + b0 * c_) * sc0);
                        w1[e] = cvt_pk_bf16((a1 * c_ - b1 * s_) * sc1, (a1 * s_ + b1 * c_) * sc1); }
                    *(PG8_GAS u32x4*)(rowp) = w0; *(PG8_GAS u32x4*)(rowp + HALF) = w1; }
            return;
        }
#pragma unroll
        for (int ai = 0; ai < 2; ++ai)
#pragma unroll
            for (int m = 0; m < 4; ++m) { bf16_t* rowp = O + (size_t)(row0 + ai * HALF + m * 16) * ldc + col0;
#pragma unroll
                for (int bj = 0; bj < 2; ++bj) { f32x4 v0 = acc[ai][bj][m][0], v1 = acc[ai][bj][m][1];
                    if (act) {
#pragma unroll
                        for (int j = 0; j < 4; ++j) { const float s0 = sigmoidf_fast(v0[j]), s1 = sigmoidf_fast(v1[j]); v0[j] = (act == 1) ? v0[j] * s0 : s0; v1[j] = (act == 1) ? v1[j] * s1 : s1; } }
                    if (ct >= 40) {
                        unsigned t0[4], t1[4];
#pragma unroll
                        for (int j = 0; j < 4; ++j) { t0[j] = __float_as_uint(v0[j] * 255.f + 8388608.f); t1[j] = __float_as_uint(v1[j] * 255.f + 8388608.f); }
                        u32x2 w; w.x = __builtin_amdgcn_perm(__builtin_amdgcn_perm(t0[3], t0[2], 0x0c0c0400u), __builtin_amdgcn_perm(t0[1], t0[0], 0x0c0c0400u), 0x05040100u);
                        w.y = __builtin_amdgcn_perm(__builtin_amdgcn_perm(t1[3], t1[2], 0x0c0c0400u), __builtin_amdgcn_perm(t1[1], t1[0], 0x0c0c0400u), 0x05040100u);
                        *(PG8_GAS u32x2*)((PG8_GAS unsigned char*)(O + (size_t)(row0 + ai * HALF + m * 16) * ldc + 40 * BM) + (col0 - 40 * BM) + bj * HALF) = w;
                    } else {
                    u32x4 w; w.x = cvt_pk_bf16(v0[0], v0[1]); w.y = cvt_pk_bf16(v0[2], v0[3]); w.z = cvt_pk_bf16(v1[0], v1[1]); w.w = cvt_pk_bf16(v1[2], v1[3]);
                    *(PG8_GAS u32x4*)(rowp + bj * HALF) = w; } } }
    }
};
struct EpiRelu2 {
    static constexpr bool PERM = true; static constexpr bool CHAIN = false;
    bf16_t* O; int ldc; const PG8_LAS float* rt;
    __device__ __forceinline__ void operator()(const f32x4 (&acc)[2][2][4][2], const Unit& u, int wr, int wc, int fr, int fq) const {
        const int row0 = u.pm * BM + wr * 64 + fr, col0 = u.pn * BM + wc * 32 + 8 * fq;
#pragma unroll
        for (int ai = 0; ai < 2; ++ai)
#pragma unroll
            for (int m = 0; m < 4; ++m) { bf16_t* rowp = O + (size_t)(row0 + ai * HALF + m * 16) * ldc + col0; const float rs = rt[row0 + ai * HALF + m * 16];
#pragma unroll
                for (int bj = 0; bj < 2; ++bj) { f32x4 v0 = acc[ai][bj][m][0], v1 = acc[ai][bj][m][1];
#pragma unroll
                    for (int j = 0; j < 4; ++j) { const float a = fmaxf(v0[j] * rs, 0.f), b = fmaxf(v1[j] * rs, 0.f); v0[j] = a * a; v1[j] = b * b; }
                    u32x4 w; w.x = cvt_pk_bf16(v0[0], v0[1]); w.y = cvt_pk_bf16(v0[2], v0[3]); w.z = cvt_pk_bf16(v1[0], v1[1]); w.w = cvt_pk_bf16(v1[2], v1[3]);
                    *(PG8_GAS u32x4*)(rowp + bj * HALF) = w; } }
    }
};
__device__ __forceinline__ float epi_sum4(float v, int a16, int a32) {
    v += __builtin_bit_cast(float, __builtin_amdgcn_ds_bpermute(a16, __builtin_bit_cast(int, v)));
    v += __builtin_bit_cast(float, __builtin_amdgcn_ds_bpermute(a32, __builtin_bit_cast(int, v)));
    return v; }
template <bool BASE_F32, bool NORM = false>
struct EpiResB {
    static constexpr bool PERM = true; static constexpr bool CHAIN = false;
    const void* base; bf16_t* out; int ldb, ldo;
    bf16_t* H; const float* gain; float* ssp; int ldh;
    __device__ __forceinline__ void emit(f32x4 v0, f32x4 v1, size_t off, size_t hoff, const f32x4 (&gn)[2], float& ss) const {
        u32x4 w; w.x = cvt_pk_bf16(v0[0], v0[1]); w.y = cvt_pk_bf16(v0[2], v0[3]); w.z = cvt_pk_bf16(v1[0], v1[1]); w.w = cvt_pk_bf16(v1[2], v1[3]);
        *(PG8_GAS u32x4*)(out + off) = w;
        if constexpr (NORM) {
            const float x0 = bf_lo(w.x), x1 = bf_hi(w.x), x2 = bf_lo(w.y), x3 = bf_hi(w.y), x4 = bf_lo(w.z), x5 = bf_hi(w.z), x6 = bf_lo(w.w), x7 = bf_hi(w.w);
            ss += ((x0 * x0 + x1 * x1) + (x2 * x2 + x3 * x3)) + ((x4 * x4 + x5 * x5) + (x6 * x6 + x7 * x7));
            (void)gn; (void)hoff; }
    }
    __device__ __forceinline__ void operator()(const f32x4 (&acc)[2][2][4][2], const Unit& u, int wr, int wc, int fr, int fq) const {
        const int row0 = u.pm * BM + wr * 64 + fr, col0 = u.pn * BM + wc * 32 + 8 * fq;
        f32x4 gn[2][2]; const int a16 = ((fr + 16 * fq) ^ 16) << 2, a32 = ((fr + 16 * fq) ^ 32) << 2;

        if constexpr (BASE_F32) {
            const float* bs = (const float*)base;
            f32x4 cur[2][2], nxt[2][2];
#define EPI_LD(dst, g_) do { const size_t off_ = (size_t)(row0 + ((g_) >> 2) * HALF + ((g_) & 3) * 16) * ldb + col0; _Pragma("unroll") for (int bj = 0; bj < 2; ++bj) _Pragma("unroll") for (int n = 0; n < 2; ++n) dst[bj][n] = *(const PG8_GAS f32x4*)(bs + off_ + bj * HALF + n * 4); } while (0)
            EPI_LD(cur, 0);
#pragma unroll
            for (int g = 0; g < 8; ++g) { const int ai = g >> 2, m = g & 3;
                if (g + 1 < 8) EPI_LD(nxt, g + 1);
                const size_t off = (size_t)(row0 + ai * HALF + m * 16) * ldo + col0;
                float ss = 0.f; const size_t hoff = (size_t)(row0 + ai * HALF + m * 16) * ldh + col0;
#pragma unroll
                for (int bj = 0; bj < 2; ++bj) { const f32x4 v0 = cur[bj][0] + acc[ai][bj][m][0], v1 = cur[bj][1] + acc[ai][bj][m][1];
                    emit(v0, v1, off + bj * HALF, hoff + bj * HALF, gn[bj], ss); }
                if constexpr (NORM) { ss = epi_sum4(ss, a16, a32); if (fq == 0) *(PG8_GAS float*)(ssp + (size_t)(row0 + ai * HALF + m * 16) * 32 + u.pn * 4 + wc) = ss; }
                asm volatile("" ::: "memory");
#pragma unroll
                for (int bj = 0; bj < 2; ++bj)
#pragma unroll
                    for (int n = 0; n < 2; ++n) cur[bj][n] = nxt[bj][n]; }
#undef EPI_LD
        } else {
            const bf16_t* bs = (const bf16_t*)base;
            u32x4 cur[2], nxt[2];
#define EPI_LD(dst, g_) do { const size_t off_ = (size_t)(row0 + ((g_) >> 2) * HALF + ((g_) & 3) * 16) * ldb + col0; _Pragma("unroll") for (int bj = 0; bj < 2; ++bj) dst[bj] = *(const PG8_GAS u32x4*)(bs + off_ + bj * HALF); } while (0)
            EPI_LD(cur, 0);
#pragma unroll
            for (int g = 0; g < 8; ++g) { const int ai = g >> 2, m = g & 3;
                if (g + 1 < 8) EPI_LD(nxt, g + 1);
                const size_t off = (size_t)(row0 + ai * HALF + m * 16) * ldo + col0;
                float ss = 0.f; const size_t hoff = (size_t)(row0 + ai * HALF + m * 16) * ldh + col0;
#pragma unroll
                for (int bj = 0; bj < 2; ++bj) { const u32x4 pw = cur[bj]; f32x4 v0 = acc[ai][bj][m][0], v1 = acc[ai][bj][m][1];
                    v0[0] += bf_lo(pw.x); v0[1] += bf_hi(pw.x); v0[2] += bf_lo(pw.y); v0[3] += bf_hi(pw.y); v1[0] += bf_lo(pw.z); v1[1] += bf_hi(pw.z); v1[2] += bf_lo(pw.w); v1[3] += bf_hi(pw.w);
                    emit(v0, v1, off + bj * HALF, hoff + bj * HALF, gn[bj], ss); }
                if constexpr (NORM) { ss = epi_sum4(ss, a16, a32); if (fq == 0) *(PG8_GAS float*)(ssp + (size_t)(row0 + ai * HALF + m * 16) * 32 + u.pn * 4 + wc) = ss; }
                asm volatile("" ::: "memory");
#pragma unroll
                for (int bj = 0; bj < 2; ++bj) cur[bj] = nxt[bj]; }
#undef EPI_LD
        }
    }
};
struct EpiBranch {
    static constexpr bool PERM = true; static constexpr bool CHAIN = true;
    bf16_t* O; int ldo; const bf16_t* G; int ldg; int gstride; int fsub;
    __device__ __forceinline__ bool mid(f32x4 (&acc)[2][2][4][2], const Unit& u, int wr, int wc, int fr, int fq) const {
        if (fsub >= 0 || u.sub != 0) return false;
        const int row0 = u.pm * BM + wr * 64 + fr, col0 = u.pn * BM + wc * 32 + 8 * fq;
        constexpr int RD = 2;
        u32x2 g0q[RD][2], g1q[RD][2];
        const PG8_GAS unsigned char* gb = (const PG8_GAS unsigned char*)(G + (size_t)row0 * ldg) + col0;
        const unsigned rstep = (unsigned)ldg * 2u;
#define EPI_LDG(slot, g_) do { const PG8_GAS unsigned char* gp_ = gb + (unsigned)(((g_) >> 2) * HALF + ((g_) & 3) * 16) * rstep; _Pragma("unroll") for (int bj = 0; bj < 2; ++bj) { \
            g0q[slot][bj] = *(const PG8_GAS u32x2*)(gp_ + bj * HALF); g1q[slot][bj] = *(const PG8_GAS u32x2*)(gp_ + gstride + bj * HALF); } } while (0)
#pragma unroll
        for (int s = 0; s < RD; ++s) EPI_LDG(s, s);
#pragma unroll
        for (int g = 0; g < 8; ++g) { const int ai = g >> 2, m = g & 3, sl = g % RD;
#pragma unroll
            for (int bj = 0; bj < 2; ++bj) { const u32x2 a = g0q[sl][bj], c = g1q[sl][bj];
#pragma unroll
                for (int n = 0; n < 2; ++n) { const unsigned aw = n ? a.y : a.x, cw = n ? c.y : c.x;
#pragma unroll
                    for (int j = 0; j < 4; ++j) { const float k0 = (float)((aw >> (8 * j)) & 0xffu), k1 = fmaxf((float)((cw >> (8 * j)) & 0xffu), 1.f);
                        acc[ai][bj][m][n][j] *= k0 * __builtin_amdgcn_rcpf(k1); } } }
            if (g + RD < 8) EPI_LDG(sl, g + RD);
            asm volatile("" ::: "memory"); }
#undef EPI_LDG
        return true;
    }
    __device__ __forceinline__ void operator()(const f32x4 (&acc)[2][2][4][2], const Unit& u, int wr, int wc, int fr, int fq) const {
        const int row0 = u.pm * BM + wr * 64 + fr, col0 = u.pn * BM + wc * 32 + 8 * fq; const int sub = fsub >= 0 ? fsub : 1; const bool pair = fsub < 0;
        u32x2 gc[2], gn[2]; u32x4 pc[2], pn[2];
#define EPI_LD(gd, pd, g_) do { const size_t r_ = (size_t)(row0 + ((g_) >> 2) * HALF + ((g_) & 3) * 16); _Pragma("unroll") for (int bj = 0; bj < 2; ++bj) { gd[bj] = *(const PG8_GAS u32x2*)((const PG8_GAS unsigned char*)(G + r_ * ldg) + sub * gstride + col0 + bj * HALF); \
            pd[bj] = (u32x4){0u, 0u, 0u, 0u}; if (pair) pd[bj] = *(const PG8_GAS u32x4*)(O + r_ * ldo + col0 + bj * HALF); } } while (0)
        EPI_LD(gc, pc, 0);
#pragma unroll
        for (int g = 0; g < 8; ++g) { const int ai = g >> 2, m = g & 3; const size_t r = (size_t)(row0 + ai * HALF + m * 16);
            if (g + 1 < 8) EPI_LD(gn, pn, g + 1);
#pragma unroll
            for (int bj = 0; bj < 2; ++bj) { u32x2 gw = gc[bj]; const u32x4 pw = pc[bj];
                float k[8] = {(float)(gw.x & 0xffu), (float)((gw.x >> 8) & 0xffu), (float)((gw.x >> 16) & 0xffu), (float)(gw.x >> 24), (float)(gw.y & 0xffu), (float)((gw.y >> 8) & 0xffu), (float)((gw.y >> 16) & 0xffu), (float)(gw.y >> 24)};
                if (pair) {
#pragma unroll
                    for (int j = 0; j < 8; ++j) k[j] = fmaxf(k[j], 1.f); }
                f32x4 v0 = acc[ai][bj][m][0] * (1.f / 255.f), v1 = acc[ai][bj][m][1] * (1.f / 255.f);
                v0[0] = v0[0] * k[0] + bf_lo(pw.x); v0[1] = v0[1] * k[1] + bf_hi(pw.x); v0[2] = v0[2] * k[2] + bf_lo(pw.y); v0[3] = v0[3] * k[3] + bf_hi(pw.y);
                v1[0] = v1[0] * k[4] + bf_lo(pw.z); v1[1] = v1[1] * k[5] + bf_hi(pw.z); v1[2] = v1[2] * k[6] + bf_lo(pw.w); v1[3] = v1[3] * k[7] + bf_hi(pw.w);
                u32x4 w; w.x = cvt_pk_bf16(v0[0], v0[1]); w.y = cvt_pk_bf16(v0[2], v0[3]); w.z = cvt_pk_bf16(v1[0], v1[1]); w.w = cvt_pk_bf16(v1[2], v1[3]);
                *(PG8_GAS u32x4*)(O + r * ldo + col0 + bj * HALF) = w; }
            asm volatile("" ::: "memory");
#pragma unroll
            for (int bj = 0; bj < 2; ++bj) { gc[bj] = gn[bj]; pc[bj] = pn[bj]; } }
#undef EPI_LD
    }
};

template <class Epi, class Sched, bool ALIGN_EPI = false, bool SP2 = false, bool FP8 = false>
__device__ __forceinline__ void gemm_phase(PG8_LAS unsigned char* lds, const Gemm g, const Sched& S, const Epi& E) {
    int tid_ = threadIdx.x; asm volatile("" : "+v"(tid_));
    const int tid = tid_, wid = __builtin_amdgcn_readfirstlane(tid >> 6), lane = tid & 63, wr = wid >> 2, wc = wid & 3, fr = lane & 15, fq = lane >> 4;
    const int K = g.K, nt = K / BK, lda = g.lda ? g.lda : g.K;
    unsigned voffA[2], voffB[2];
#pragma unroll
    for (int i = 0; i < 2; ++i) { int R, C; stage_rc(tid * 16 + i * 8192, R, C); const int Rb = Epi::PERM ? ((R & ~31) + perm32(R & 31)) : R;
        voffA[i] = (unsigned)(R * lda + C) * 2u; voffB[i] = (unsigned)(Rb * K + C) * 2u; }
    const size_t kstep = (size_t)(BK * 2);
    const size_t hstep = (size_t)HALF * K * 2, hstepA = (size_t)HALF * lda * 2;
    const size_t tstep = 2 * hstep, tstepA = 2 * hstepA;
    const unsigned ldsw = (unsigned)wid * 1024u;
    const int aoff = lds_byte(wr * 64 + fr, fq * 8), boff = lds_byte(wc * 32 + fr, fq * 8);
#define PG8_SA(b, h) (((b) * 2 + (h)) * HTB)
#define PG8_SB(b, h) ((4 + (b) * 2 + (h)) * HTB)
#define PG8_STAGE(bufoff, gbase, voff) do { _Pragma("unroll") for (int _i = 0; _i < 2; ++_i) \
        __builtin_amdgcn_global_load_lds((const unsigned*)((const char*)(gbase) + (voff)[_i]), (PG8_LAS unsigned*)(lds + (bufoff) + ldsw + _i * 8192), 16, 0, 0); } while (0)
#define PG8_LDA(dst, b, h) do { _Pragma("unroll") for (int m = 0; m < 4; ++m) { if constexpr (FP8) { const v4i32 lo_ = *(const PG8_LAS v4i32*)(lds + PG8_SA(b, h) + aoff + m * 2048), hi_ = *(const PG8_LAS v4i32*)(lds + PG8_SA(b, h) + aoff + m * 2048 + 1024); dst##8[m] = __builtin_shufflevector(lo_, hi_, 0, 1, 2, 3, 4, 5, 6, 7); } \
        else { _Pragma("unroll") for (int k = 0; k < 2; ++k) dst[m][k] = *(const PG8_LAS bf16x8*)(lds + PG8_SA(b, h) + aoff + m * 2048 + k * 1024); } } } while (0)
#define PG8_LDB(dst, b, h) do { _Pragma("unroll") for (int n = 0; n < 2; ++n) { if constexpr (FP8) { const v4i32 lo_ = *(const PG8_LAS v4i32*)(lds + PG8_SB(b, h) + boff + n * 2048), hi_ = *(const PG8_LAS v4i32*)(lds + PG8_SB(b, h) + boff + n * 2048 + 1024); dst##8[n] = __builtin_shufflevector(lo_, hi_, 0, 1, 2, 3, 4, 5, 6, 7); } \
        else { _Pragma("unroll") for (int k = 0; k < 2; ++k) dst[n][k] = *(const PG8_LAS bf16x8*)(lds + PG8_SB(b, h) + boff + n * 2048 + k * 1024); } } } while (0)
#define PG8_MMA(ai, bj, At, Bt) do { __builtin_amdgcn_s_setprio(1); _Pragma("unroll") for (int m = 0; m < 4; ++m) _Pragma("unroll") for (int n = 0; n < 2; ++n) { \
        if constexpr (FP8) asm volatile("v_mfma_scale_f32_16x16x128_f8f6f4 %0, %1, %2, %0, %3, %4 op_sel_hi:[0,0,0]" : "+v"(acc[ai][bj][m][n]) : "v"(Bt##8[n]), "v"(At##8[m]), "v"(sc_w8), "v"(sc_a8));   \
        else { _Pragma("unroll") for (int k = 0; k < 2; ++k) acc[ai][bj][m][n] = __builtin_amdgcn_mfma_f32_16x16x32_bf16(Bt[n][k], At[m][k], acc[ai][bj][m][n], 0, 0, 0); } } \
        __builtin_amdgcn_s_setprio(0); } while (0)
#define PG8_WAIT_V(n) asm volatile("s_waitcnt vmcnt(" #n ")" ::: "memory")
#define PG8_WAIT_L(n) asm volatile("s_waitcnt lgkmcnt(" #n ")" ::: "memory")
#define PG8_BAR __builtin_amdgcn_s_barrier()
#define PG8_SCHED __builtin_amdgcn_sched_barrier(0)
#define PG8_UA(u) ((const char*)g.A + (size_t)(u).pm * tstepA + (size_t)(u).sub * g.subA)
#define PG8_UB(u) ((const char*)g.Bt + (size_t)(u).pn * tstep + (size_t)(u).sub * g.subB)
    Unit cur, nxt; int ui = 0;
    if (!S.next(0, cur)) return;
    f32x4 acc[2][2][4][2];
#pragma unroll
    for (int a = 0; a < 2; ++a)
#pragma unroll
        for (int b = 0; b < 2; ++b)
#pragma unroll
            for (int m = 0; m < 4; ++m)
#pragma unroll
                for (int n = 0; n < 2; ++n) acc[a][b][m][n] = (f32x4){0.f, 0.f, 0.f, 0.f};
    bf16x8 At[4][2], B0[2][2], B1[2][2];
    v8i32 At8[4], B08[2], B18[2];
    const int sc_w8 = 0x79797979, sc_a8 = 0x7f7f7f7f;
    const char* cA = PG8_UA(cur); const char* cB = PG8_UB(cur);
    S.a_ready(cur);
    if constexpr (SP2) {
        PG8_STAGE(PG8_SB(0, 0), cB, voffB); PG8_STAGE(PG8_SB(0, 1), cB + hstep, voffB); PG8_STAGE(PG8_SA(0, 0), cA, voffA); PG8_STAGE(PG8_SA(0, 1), cA + hstepA, voffA);
        if (wr == 1) PG8_BAR;
        PG8_WAIT_V(2); PG8_BAR;
        PG8_STAGE(PG8_SB(1, 0), cB + kstep, voffB); PG8_STAGE(PG8_SA(1, 0), cA + kstep, voffA); PG8_STAGE(PG8_SB(1, 1), cB + hstep + kstep, voffB);
        PG8_WAIT_V(6); PG8_BAR;
    } else {
        PG8_STAGE(PG8_SB(0, 0), cB, voffB); PG8_STAGE(PG8_SA(0, 0), cA, voffA); PG8_STAGE(PG8_SB(0, 1), cB + hstep, voffB); PG8_STAGE(PG8_SA(0, 1), cA + hstepA, voffA);
        if (wr == 1) PG8_BAR;
        PG8_WAIT_V(4); PG8_BAR;
        PG8_STAGE(PG8_SB(1, 0), cB + kstep, voffB); PG8_STAGE(PG8_SA(1, 0), cA + kstep, voffA); PG8_STAGE(PG8_SB(1, 1), cB + hstep + kstep, voffB);
        PG8_WAIT_V(6); PG8_BAR;
    }
    for (;;) {
        const bool has_next = S.next(ui + 1, nxt);
        const char* nA = has_next ? PG8_UA(nxt) : cA; const char* nB = has_next ? PG8_UB(nxt) : cB;
        for (int t = 0; t < nt; t += 2) {
            const bool last = (t == nt - 2);
            const char* a1 = cA + (size_t)(t + 1) * kstep;
            const char* a2 = last ? nA : cA + (size_t)(t + 2) * kstep; const char* b2 = last ? nB : cB + (size_t)(t + 2) * kstep;
            const char* a3 = a2 + kstep; const char* b3 = b2 + kstep;
            if (last && has_next) S.a_ready(nxt);
            if constexpr (SP2) {
            PG8_LDB(B0, 0, 0); PG8_LDB(B1, 0, 1); PG8_SCHED; PG8_LDA(At, 0, 0); PG8_STAGE(PG8_SA(1, 1), a1 + hstepA, voffA);
            PG8_WAIT_V(8); PG8_WAIT_L(0); PG8_BAR; PG8_MMA(0, 0, At, B0); PG8_MMA(0, 1, At, B1); PG8_BAR; PG8_SCHED;
            PG8_LDA(At, 0, 1); PG8_STAGE(PG8_SB(0, 0), b2, voffB); PG8_STAGE(PG8_SB(0, 1), b2 + hstep, voffB); PG8_STAGE(PG8_SA(0, 0), a2, voffA);
            PG8_WAIT_V(8); PG8_WAIT_L(0); PG8_BAR; PG8_MMA(1, 0, At, B0); PG8_MMA(1, 1, At, B1); PG8_BAR; PG8_SCHED;
            PG8_LDB(B0, 1, 0); PG8_LDB(B1, 1, 1); PG8_SCHED; PG8_LDA(At, 1, 0); PG8_STAGE(PG8_SA(0, 1), a2 + hstepA, voffA);
            PG8_WAIT_V(8); PG8_WAIT_L(0); PG8_BAR; PG8_MMA(0, 0, At, B0); PG8_MMA(0, 1, At, B1); PG8_BAR; PG8_SCHED;
            PG8_LDA(At, 1, 1); PG8_STAGE(PG8_SB(1, 0), b3, voffB); PG8_STAGE(PG8_SB(1, 1), b3 + hstep, voffB); PG8_STAGE(PG8_SA(1, 0), a3, voffA);
            PG8_WAIT_V(8); PG8_WAIT_L(0); PG8_BAR; PG8_MMA(1, 0, At, B0); PG8_MMA(1, 1, At, B1); PG8_BAR; PG8_SCHED;
            } else {
            PG8_LDB(B0, 0, 0); PG8_SCHED; PG8_LDA(At, 0, 0); PG8_STAGE(PG8_SA(1, 1), a1 + hstepA, voffA);
            PG8_WAIT_L(8); PG8_BAR; PG8_WAIT_L(0); PG8_MMA(0, 0, At, B0); PG8_BAR; PG8_SCHED;
            PG8_LDB(B1, 0, 1); PG8_STAGE(PG8_SB(0, 0), b2, voffB);
            PG8_BAR; PG8_WAIT_L(0); PG8_MMA(0, 1, At, B1); PG8_BAR;
            PG8_LDA(At, 0, 1); PG8_STAGE(PG8_SA(0, 0), a2, voffA);
            PG8_BAR; PG8_WAIT_L(0); PG8_MMA(1, 0, At, B0); PG8_BAR; PG8_SCHED;
            PG8_STAGE(PG8_SB(0, 1), b2 + hstep, voffB);
            PG8_WAIT_V(6); PG8_BAR; PG8_MMA(1, 1, At, B1); PG8_BAR;
            PG8_LDB(B0, 1, 0); PG8_SCHED; PG8_LDA(At, 1, 0); PG8_STAGE(PG8_SA(0, 1), a2 + hstepA, voffA);
            PG8_WAIT_L(8); PG8_BAR; PG8_WAIT_L(0); PG8_MMA(0, 0, At, B0); PG8_BAR; PG8_SCHED;
            PG8_LDB(B1, 1, 1); PG8_STAGE(PG8_SB(1, 0), b3, voffB);
            PG8_BAR; PG8_WAIT_L(0); PG8_MMA(0, 1, At, B1); PG8_BAR;
            PG8_LDA(At, 1, 1); PG8_STAGE(PG8_SA(1, 0), a3, voffA);
            PG8_BAR; PG8_WAIT_L(0); PG8_MMA(1, 0, At, B0); PG8_BAR; PG8_SCHED;
            PG8_STAGE(PG8_SB(1, 1), b3 + hstep, voffB);
            PG8_WAIT_V(6); PG8_BAR; PG8_MMA(1, 1, At, B1); PG8_BAR;
            }
        }
        if constexpr (FP8) asm volatile("s_nop 15\n\ts_nop 15" ::: "memory");
        if constexpr (ALIGN_EPI) { if (wr == 0) PG8_BAR; }
        bool keep = false;
        if constexpr (Epi::CHAIN) keep = E.mid(acc, cur, wr, wc, fr, fq);
        if (!keep) E(acc, cur, wr, wc, fr, fq);
        S.done(cur);
        if (!has_next) break;
        if (!keep)
#pragma unroll
        for (int a = 0; a < 2; ++a)
#pragma unroll
            for (int b = 0; b < 2; ++b)
#pragma unroll
                for (int m = 0; m < 4; ++m)
#pragma unroll
                    for (int n = 0; n < 2; ++n) acc[a][b][m][n] = (f32x4){0.f, 0.f, 0.f, 0.f};
        cur = nxt; cA = nA; cB = nB; ++ui;
        if constexpr (ALIGN_EPI) { if (wr == 1) PG8_BAR; }
    }
    PG8_WAIT_V(0);
    if constexpr (!ALIGN_EPI) { if (wr == 0) PG8_BAR; }
    PG8_BAR;
#undef PG8_SA
#undef PG8_SB
#undef PG8_STAGE
#undef PG8_LDA
#undef PG8_LDB
#undef PG8_MMA
#undef PG8_WAIT_V
#undef PG8_WAIT_L
#undef PG8_BAR
#undef PG8_SCHED
#undef PG8_UA
#undef PG8_UB
}
}

using pg8::bf_lo; using pg8::bf_hi; using pg8::cvt_pk_bf16; using pg8::sigmoidf_fast;

constexpr int NWAVES = 8;
constexpr int DM = 2048, BATCH = 16, SEQ = 2048, DEPTH = 2, DFF = 8192;
constexpr int DIN_SRC = 16392;
constexpr int NPROJ = 16384, NP16 = 6144, NP8 = NPROJ - NP16;
constexpr float W8_SCALE = 64.f;
constexpr int NTEAM = MK_NTEAM, GPT = 2, XPT = 8 / NTEAM;
constexpr int GB = BATCH / (NTEAM * GPT), MG = GB * SEQ, NGROUP = BATCH / GB;
constexpr int NIT = DEPTH * GPT;
constexpr int C_RQ = 0, C_RK = 1024, C_RV = 2048, C_RG = 3072, C_MQ = 4096, C_MK = 4608, C_MV = 5120, C_MO = 6144, C_BQ = 7168, C_BK = 8192, C_BV = 9216, C_GATE = 10240;
constexpr int SRC_GATECOL = 7168;
constexpr float EPS = 1e-6f;
constexpr float LOG2E = 1.4426950408889634f;
constexpr float QSCALE = 0.08838834764831845f;


constexpr size_t MiB = 1u << 20;
constexpr size_t WS_CTL = 0, CTL_ZERO_BYTES = 2 * MiB;
constexpr size_t SZ_WIN = (size_t)NP16 * DM * 2, SZ_WIN8 = (size_t)NP8 * DM, SZ_WBR = (size_t)3 * DM * 1024 * 2, SZ_WOUT = (size_t)DM * DM * 2, SZ_WFF = (size_t)DFF * DM * 2;
constexpr size_t WS_WIN = 2 * MiB;
constexpr size_t WS_WBR = WS_WIN + DEPTH * SZ_WIN;
constexpr size_t WS_WOUT = WS_WBR + DEPTH * SZ_WBR;
constexpr size_t WS_WFF1 = WS_WOUT + DEPTH * SZ_WOUT;
constexpr size_t WS_WFF2 = WS_WFF1 + DEPTH * SZ_WFF;
constexpr size_t WS_WG = WS_WFF2 + DEPTH * SZ_WFF;
constexpr size_t WS_WIN8 = WS_WG + 1 * MiB;
constexpr size_t WS_WBR8 = WS_WIN8 + DEPTH * SZ_WIN8;
constexpr size_t SZ_WBR8 = (size_t)DM * 1024;
constexpr size_t WS_ACT = WS_WBR8 + DEPTH * SZ_WBR8;
constexpr size_t WS_HB = 0;
constexpr size_t WS_MIXED = WS_HB;
constexpr size_t WS_GP = WS_HB + (size_t)MG * DM * 2;
constexpr size_t WS_A2 = WS_GP + (size_t)MG * 8 * 4;
constexpr size_t WS_NM = WS_A2 + (size_t)MG * 4 * 4;
constexpr size_t WS_KSC = WS_NM + (size_t)MG * 4 * 4;
constexpr size_t WS_BMAX = WS_KSC + (size_t)MG * 4 * 4;
constexpr size_t WS_KMEAN = WS_BMAX + 64 * 1024;
constexpr size_t WS_MQK = WS_KMEAN + (size_t)GB * 8 * 8 * 128 * 4;
constexpr size_t WS_Y = WS_MQK + (size_t)MG * 1024 * 2;
constexpr size_t WS_MST_IMG = WS_HB;
constexpr size_t WS_MST_Z = WS_HB + 4 * MiB;
constexpr size_t WS_MST_R = WS_MST_Z + 64 * 1024;
static_assert(WS_MST_R + 4096 <= WS_HB + (size_t)MG * DM * 2, "mLSTM state images fit in the hidden-state buffer");
constexpr size_t WS_HRAW = WS_Y;
constexpr size_t WS_SSP = WS_Y + (size_t)MG * DM * 2;
static_assert((size_t)MG * DM * 2 + (size_t)MG * 32 * 4 <= (size_t)3 * MG * 1024 * 2, "HRAW + SSP fit in Y");
constexpr size_t WS_HB8 = WS_Y + (size_t)3 * MG * 1024 * 2;
constexpr size_t WS_PROJ = WS_HB8 + (size_t)MG * DM;
constexpr size_t TEAM_STRIDE = WS_PROJ + (size_t)MG * NPROJ * 2;
constexpr size_t WS_END = WS_ACT + NTEAM * TEAM_STRIDE;
static_assert(WS_END <= (size_t)1020 * MiB, "workspace map");
constexpr int CW_TMO = 0, CW_CODE = 1;
constexpr int CW_Q2 = 2048, CW_FLAG = 1536;
constexpr int CW_BAR = 4096;

constexpr int RING_OFF = 0, RING_BYTES = 131072;
constexpr int LDSCTL_OFF = RING_BYTES, MISC_OFF = LDSCTL_OFF + 320;
constexpr int LDS_BYTES = 147456;
constexpr int RSTD_OFF = LDSCTL_OFF + 1024;
static_assert(MISC_OFF + 128 <= RSTD_OFF && RSTD_OFF + 2048 * 4 <= LDS_BYTES, "LDS map");

#define GAS __attribute__((address_space(1)))
#define LAS __attribute__((address_space(3)))
typedef unsigned short bf16;
typedef unsigned v4u __attribute__((ext_vector_type(4)));
typedef unsigned v2u __attribute__((ext_vector_type(2)));
typedef float f32x4 __attribute__((ext_vector_type(4)));
typedef __bf16 bfp2 __attribute__((ext_vector_type(2)));
typedef GAS unsigned gu32;
#define RLX_AGENT __ATOMIC_RELAXED, __HIP_MEMORY_SCOPE_AGENT
#define LDS_WAIT() asm volatile("s_waitcnt lgkmcnt(0)" ::: "memory")
#define VM_WAIT() asm volatile("s_waitcnt vmcnt(0)" ::: "memory")
__device__ __forceinline__ unsigned f2bf(float f) { unsigned u = __builtin_bit_cast(unsigned, f); return (u + 0x7fffu + ((u >> 16) & 1u)) >> 16; }
__device__ __forceinline__ unsigned pk2(float lo, float hi) { return f2bf(lo) | (f2bf(hi) << 16); }
__device__ __forceinline__ float dot2bf(unsigned a, unsigned b, float c) { return __builtin_amdgcn_fdot2_f32_bf16(__builtin_bit_cast(bfp2, a), __builtin_bit_cast(bfp2, b), c, false); }

#define XB_TMO      128
#define XB_XCNT(j)  (256  + 64 * (j))
#define XB_XSUB(j)  (1280 + 64 * (j))
#define XB_XGEN(j)  (2304 + 64 * (j))
#define XB_TOP      3328
#define XB_TOPGEN   3392
#define XCD_BAR_WORDS 3456
#define XB_SPIN_CAP (1u << 18)

__device__ __forceinline__ unsigned xb_ld(unsigned* p)              { return __hip_atomic_load(p, __ATOMIC_RELAXED, __HIP_MEMORY_SCOPE_AGENT); }
__device__ __forceinline__ unsigned xb_add(unsigned* p, unsigned v) { return __hip_atomic_fetch_add(p, v, __ATOMIC_RELAXED, __HIP_MEMORY_SCOPE_AGENT); }
__device__ __forceinline__ unsigned xb_xcc_id() { return (unsigned)__builtin_amdgcn_s_getreg((3 << 11) | 20) & 0xFu; }
#define XB_SPIN(cond, bar) do { unsigned _sp = 0; while (cond) { __builtin_amdgcn_s_sleep(1); \
    if ((++_sp & 255u) == 0u) { if (xb_ld(&(bar)[XB_TMO])) break; if (_sp > XB_SPIN_CAP) { atomicAdd(&(bar)[XB_TMO], 1u); break; } } } } while (0)

struct XcdBarrier { unsigned* bar; unsigned x; volatile LAS unsigned* st; unsigned G; };

__device__ __forceinline__ XcdBarrier xcd_barrier_post(unsigned* bar, volatile LAS unsigned* st, unsigned G) {
    XcdBarrier b; b.bar = bar; b.x = xb_xcc_id(); b.st = st; b.G = G;
    if (threadIdx.x == 0) (void)xb_add(&bar[XB_XCNT(b.x)], 1u);
    return b;
}
__device__ __forceinline__ void xcd_barrier_complete(unsigned* bar, unsigned x, unsigned& nloc, unsigned& nx, const unsigned G) {
    unsigned sum, cnt, mine, sp = 0u;
    for (;;) {
        sum = 0u; cnt = 0u; mine = 0u;
#pragma unroll
        for (unsigned j = 0; j < 16; ++j) { const unsigned c = xb_ld(&bar[XB_XCNT(j)]); sum += c; cnt += (c > 0u) ? 1u : 0u; mine = (j == x) ? c : mine; }
        if (sum == G) break;
        __builtin_amdgcn_s_sleep(1);
        if ((++sp & 255u) == 0u) { if (xb_ld(&bar[XB_TMO])) break; if (sp > XB_SPIN_CAP) { atomicAdd(&bar[XB_TMO], 1u); break; } }
    }
    nloc = mine > 0u ? mine : 1u; nx = cnt > 0u ? cnt : 1u;
}
__device__ __forceinline__ void xcd_barrier(const XcdBarrier& b) {
    asm volatile("s_waitcnt vmcnt(0)" ::: "memory");
    __syncthreads();
    if (threadIdx.x == 0) {
        unsigned* bar = b.bar;
        __builtin_amdgcn_s_waitcnt(0);
        unsigned nloc = b.st[0], nx = b.st[1];
        if (nloc == 0u) { xcd_barrier_complete(bar, b.x, nloc, nx, b.G); b.st[0] = nloc; b.st[1] = nx; }
        const unsigned old = xb_add(&bar[XB_XSUB(b.x)], 1u);
        const unsigned gen = old / nloc;
        if (old + 1u == (gen + 1u) * nloc) {
            __builtin_amdgcn_fence(__ATOMIC_RELEASE, "agent");
            asm volatile("s_waitcnt vmcnt(0)" ::: "memory");
            const unsigned og = xb_add(&bar[XB_TOP], 1u);
            const unsigned tg = og / nx;
            if (og + 1u == (tg + 1u) * nx) xb_add(&bar[XB_TOPGEN], 1u);
            else XB_SPIN(xb_ld(&bar[XB_TOPGEN]) == tg, bar);
            __builtin_amdgcn_fence(__ATOMIC_ACQUIRE, "agent");
            xb_add(&bar[XB_XGEN(b.x)], 1u);
            asm volatile("s_waitcnt vmcnt(0)" ::: "memory");
        } else {
            XB_SPIN(xb_ld(&bar[XB_XGEN(b.x)]) == gen, bar);
            __builtin_amdgcn_fence(__ATOMIC_ACQUIRE, "agent");
            asm volatile("s_waitcnt vmcnt(0)" ::: "memory");
        }
    }
    __syncthreads();
}

struct Frame {
    LAS unsigned char* lds;
    volatile LAS unsigned* MISC;
    gu32* ctl;
    int tid, lane, wave;
    int vcu, G;
    int bidx, team;
    unsigned char* ws;
    unsigned char* wsw;
    float* out;
};
__device__ __forceinline__ Frame relocal(const Frame& F0) { Frame F = F0; int t = threadIdx.x; asm volatile("" : "+v"(t)); F.tid = t; F.lane = t & 63; F.wave = __builtin_amdgcn_readfirstlane(t >> 6);
    asm volatile("" : "+s"(F.ws)); asm volatile("" : "+s"(F.wsw)); asm volatile("" : "+s"(F.out)); return F; }
__device__ __forceinline__ unsigned char* opq(unsigned char* p) { asm volatile("" : "+s"(p)); return p; }
template <int X> __device__ __forceinline__ float swz_xor(float v) {
    return __uint_as_float((unsigned)__builtin_amdgcn_ds_swizzle((int)__float_as_uint(v), (X << 10) | 0x1f)); }
__device__ __forceinline__ float sum_xor32(float v) { auto r = __builtin_amdgcn_permlane32_swap(__float_as_uint(v), __float_as_uint(v), false, false); return __uint_as_float(r[0]) + __uint_as_float(r[1]); }
__device__ __forceinline__ float max_xor32(float v) { auto r = __builtin_amdgcn_permlane32_swap(__float_as_uint(v), __float_as_uint(v), false, false); return fmaxf(__uint_as_float(r[0]), __uint_as_float(r[1])); }
__device__ __forceinline__ float wave_sum(float v) { v += swz_xor<1>(v); v += swz_xor<2>(v); v += swz_xor<4>(v); v += swz_xor<8>(v); v += swz_xor<16>(v); return sum_xor32(v); }
__device__ __forceinline__ float wave_max(float v) { v = fmaxf(v, swz_xor<1>(v)); v = fmaxf(v, swz_xor<2>(v)); v = fmaxf(v, swz_xor<4>(v)); v = fmaxf(v, swz_xor<8>(v)); v = fmaxf(v, swz_xor<16>(v)); return max_xor32(v); }

__device__ __forceinline__ void p0_transpose_item(const float* W, int K, int N, int Nsrc, bool shift8, bf16* WT, LAS float* scr, int item, int lane, const float* kscale = nullptr) {
    const int nblk = N / 32, kb = item / nblk, nb = item % nblk, k0 = 64 * kb, n0 = 32 * nb;
    const int cp = n0 + (lane & 31);
    const int csrc = (shift8 && n0 < 2048) ? ((cp & ~127) + ((cp & 1) << 6) + ((cp & 127) >> 1)) : cp;
    float tv[32];
#pragma unroll
    for (int i = 0; i < 32; ++i) tv[i] = W[(size_t)(k0 + 2 * i + (lane >> 5)) * Nsrc + csrc];
    if (kscale) {
#pragma unroll
        for (int i = 0; i < 32; ++i) tv[i] *= kscale[k0 + 2 * i + (lane >> 5)]; }
#pragma unroll
    for (int i = 0; i < 32; ++i) scr[(2 * i + (lane >> 5)) * 33 + (lane & 31)] = tv[i];
    LDS_WAIT(); asm volatile("" ::: "memory");
    const int c = lane & 7;
#pragma unroll
    for (int j = 0; j < 4; ++j) { const int n = (lane >> 3) + 8 * j; const LAS float* s = scr + (8 * c) * 33 + n;
        v4u o; o.x = pk2(s[0 * 33], s[1 * 33]); o.y = pk2(s[2 * 33], s[3 * 33]); o.z = pk2(s[4 * 33], s[5 * 33]); o.w = pk2(s[6 * 33], s[7 * 33]);
        *(GAS v4u*)(WT + (size_t)(n0 + n) * K + k0 + 8 * c) = o; }
    LDS_WAIT(); asm volatile("" ::: "memory");
}

__device__ __forceinline__ unsigned pk4_fp8(float a, float b, float c, float d) { int w = 0; w = __builtin_amdgcn_cvt_pk_fp8_f32(a, b, w, false); w = __builtin_amdgcn_cvt_pk_fp8_f32(c, d, w, true); return (unsigned)w; }
__device__ __forceinline__ void p0_transpose_item_fp8(const float* W, int K, int N, int Nsrc, int srcoff, unsigned char* WT, LAS float* scr, int item, int lane, bool gatefix = true) {
    const int nblk = N / 32, kb = item / nblk, nb = item % nblk, k0 = 64 * kb, n0 = 32 * nb, ns0 = n0 + srcoff + ((gatefix && n0 + srcoff >= SRC_GATECOL) ? 8 : 0);
    float tv[32];
#pragma unroll
    for (int i = 0; i < 32; ++i) tv[i] = W[(size_t)(k0 + 2 * i + (lane >> 5)) * Nsrc + ns0 + (lane & 31)];
#pragma unroll
    for (int i = 0; i < 32; ++i) scr[(2 * i + (lane >> 5)) * 33 + (lane & 31)] = tv[i];
    LDS_WAIT(); asm volatile("" ::: "memory");
    const int n = lane >> 1, kh = (lane & 1) * 32; const LAS float* s = scr + kh * 33 + n;
    v4u o0, o1;
    o0.x = pk4_fp8(s[0 * 33] * W8_SCALE, s[1 * 33] * W8_SCALE, s[2 * 33] * W8_SCALE, s[3 * 33] * W8_SCALE); o0.y = pk4_fp8(s[4 * 33] * W8_SCALE, s[5 * 33] * W8_SCALE, s[6 * 33] * W8_SCALE, s[7 * 33] * W8_SCALE);
    o0.z = pk4_fp8(s[8 * 33] * W8_SCALE, s[9 * 33] * W8_SCALE, s[10 * 33] * W8_SCALE, s[11 * 33] * W8_SCALE); o0.w = pk4_fp8(s[12 * 33] * W8_SCALE, s[13 * 33] * W8_SCALE, s[14 * 33] * W8_SCALE, s[15 * 33] * W8_SCALE);
    o1.x = pk4_fp8(s[16 * 33] * W8_SCALE, s[17 * 33] * W8_SCALE, s[18 * 33] * W8_SCALE, s[19 * 33] * W8_SCALE); o1.y = pk4_fp8(s[20 * 33] * W8_SCALE, s[21 * 33] * W8_SCALE, s[22 * 33] * W8_SCALE, s[23 * 33] * W8_SCALE);
    o1.z = pk4_fp8(s[24 * 33] * W8_SCALE, s[25 * 33] * W8_SCALE, s[26 * 33] * W8_SCALE, s[27 * 33] * W8_SCALE); o1.w = pk4_fp8(s[28 * 33] * W8_SCALE, s[29 * 33] * W8_SCALE, s[30 * 33] * W8_SCALE, s[31 * 33] * W8_SCALE);
    GAS v4u* dst = (GAS v4u*)(WT + (size_t)(n0 + n) * K + k0 + kh); dst[0] = o0; dst[1] = o1;
    LDS_WAIT(); asm volatile("" ::: "memory");
}
struct Args { const float* in[16]; float* out; unsigned char* ws; };
typedef const __attribute__((address_space(4))) Args* KArgs;
__device__ __forceinline__ KArgs kargs() { KArgs p = (KArgs)__builtin_amdgcn_kernarg_segment_ptr(); asm volatile("" : "+s"(p)); return p; }

constexpr int PRO_I_IN16 = (DM / 64) * (NP16 / 32), PRO_I_IN = (DM / 64) * (NPROJ / 32), PRO_I_BR = (1024 / 64) * (DM / 32), PRO_I_OUT = (DM / 64) * (DM / 32), PRO_I_F1 = (DM / 64) * (DFF / 32), PRO_I_F2 = (DFF / 64) * (DM / 32);
constexpr int PRO_PER_L = PRO_I_IN + 3 * PRO_I_BR + PRO_I_OUT + PRO_I_F1 + PRO_I_F2;
__device__ __forceinline__ void phase_prologue(const Frame& F0, KArgs a, int i0, int i1, int wg, int nwg, bool gates) { Frame F = relocal(F0);
    LAS float* scr = (LAS float*)(F.lds + RING_OFF + F.wave * 16384);
    const int gw = wg * NWAVES + F.wave, NGW = nwg * NWAVES;
    constexpr int I_IN = PRO_I_IN, I_BR = PRO_I_BR, I_OUT = PRO_I_OUT, I_F1 = PRO_I_F1, PER_L = PRO_PER_L;
    for (int it = i0 + gw; it < i1; it += NGW) {
        const int l = it / PER_L; int r = it - l * PER_L;
        if (r < PRO_I_IN16) { p0_transpose_item(a->in[1] + (size_t)l * DM * DIN_SRC, DM, NP16, DIN_SRC, true, (bf16*)(F.wsw + WS_WIN + l * SZ_WIN), scr, r, F.lane); continue; }
        if (r < I_IN) { p0_transpose_item_fp8(a->in[1] + (size_t)l * DM * DIN_SRC, DM, NP8, DIN_SRC, NP16, F.wsw + WS_WIN8 + l * SZ_WIN8, scr, r - PRO_I_IN16, F.lane); continue; } r -= I_IN;
        if (r < 3 * I_BR) { const int br = r / I_BR; r -= br * I_BR;
            if (br == 2) { p0_transpose_item_fp8(a->in[8] + (size_t)l * 1024 * DM, 1024, DM, DM, 0, F.wsw + WS_WBR8 + l * SZ_WBR8, scr, r, F.lane, false); continue; }
            p0_transpose_item(a->in[6 + br] + (size_t)l * 1024 * DM, 1024, DM, DM, false, (bf16*)(F.wsw + WS_WBR + l * SZ_WBR + (size_t)br * DM * 1024 * 2), scr, r, F.lane); continue; } r -= 3 * I_BR;
        if (r < I_OUT) { p0_transpose_item(a->in[9] + (size_t)l * DM * DM, DM, DM, DM, false, (bf16*)(F.wsw + WS_WOUT + l * SZ_WOUT), scr, r, F.lane); continue; } r -= I_OUT;
        if (r < I_F1) { p0_transpose_item(a->in[12] + (size_t)l * DM * DFF, DM, DFF, DFF, false, (bf16*)(F.wsw + WS_WFF1 + l * SZ_WFF), scr, r, F.lane, a->in[11] + (size_t)l * DM); continue; } r -= I_F1;
        p0_transpose_item(a->in[13] + (size_t)l * DFF * DM, DFF, DM, DM, false, (bf16*)(F.wsw + WS_WFF2 + l * SZ_WFF), scr, r, F.lane);
    }
    if (gates) {
        float* WG = (float*)(F.wsw + WS_WG);
        for (int i = gw * 64 + F.lane; i < DEPTH * 8 * DM; i += NGW * 64) { const int l = i / (8 * DM), j = (i / DM) % 8, k = i % DM;
            WG[i] = a->in[1][(size_t)l * DM * DIN_SRC + (size_t)k * DIN_SRC + SRC_GATECOL + j]; } }
}

__device__ __forceinline__ void row_load(const float* xrow, int lane, f32x4 (&v)[8]) { const GAS f32x4* xr = (const GAS f32x4*)xrow + lane;
#pragma unroll
    for (int j = 0; j < 8; ++j) v[j] = xr[64 * j]; }
__device__ __forceinline__ void rms_apply(const float* gain, int lane, f32x4 (&hv)[8]) {
    float s = 0.f;
#pragma unroll
    for (int j = 0; j < 8; ++j) s += (hv[j].x * hv[j].x + hv[j].y * hv[j].y) + (hv[j].z * hv[j].z + hv[j].w * hv[j].w);
    const float rstd = 1.0f / sqrtf(wave_sum(s) * (1.f / DM) + EPS);
    const GAS f32x4* gr = (const GAS f32x4*)gain + lane;
#pragma unroll
    for (int j = 0; j < 8; ++j) hv[j] = hv[j] * rstd * gr[64 * j];
}
__device__ __forceinline__ void store_row_bf16(bf16* orow, int lane, const f32x4 (&hv)[8]) {
    GAS unsigned long long* o8 = (GAS unsigned long long*)orow + lane;
#pragma unroll
    for (int j = 0; j < 8; ++j) o8[64 * j] = (unsigned long long)pk2(hv[j].x, hv[j].y) | ((unsigned long long)pk2(hv[j].z, hv[j].w) << 32);
}
__device__ __forceinline__ void rms_apply_g(const f32x4 (&g)[8], f32x4 (&hv)[8]) {
    float s = 0.f;
#pragma unroll
    for (int j = 0; j < 8; ++j) s += (hv[j].x * hv[j].x + hv[j].y * hv[j].y) + (hv[j].z * hv[j].z + hv[j].w * hv[j].w);
    const float rstd = 1.0f / sqrtf(wave_sum(s) * (1.f / DM) + EPS);
#pragma unroll
    for (int j = 0; j < 8; ++j) hv[j] = hv[j] * rstd * g[j];
}
__device__ __forceinline__ float reduce8(const float (&a)[8], int lane) {
    const bool b0 = lane & 1, b1 = lane & 2, b2 = lane & 4;
    float b[4], c[2];
#pragma unroll
    for (int i = 0; i < 4; ++i) { const float send = b0 ? a[i] : a[i + 4], keep = b0 ? a[i + 4] : a[i]; b[i] = keep + swz_xor<1>(send); }
#pragma unroll
    for (int i = 0; i < 2; ++i) { const float send = b1 ? b[i] : b[i + 2], keep = b1 ? b[i + 2] : b[i]; c[i] = keep + swz_xor<2>(send); }
    float d; { const float send = b2 ? c[0] : c[1], keep = b2 ? c[1] : c[0]; d = keep + swz_xor<4>(send); }
    d += swz_xor<8>(d); d += swz_xor<16>(d); return sum_xor32(d);
}
template <bool BF> struct RowBuf;
template <> struct RowBuf<false> { f32x4 r[8];
    __device__ __forceinline__ void load(const float* slot, int lane) { const GAS f32x4* p = (const GAS f32x4*)slot + lane;
#pragma unroll
        for (int j = 0; j < 8; ++j) r[j] = p[64 * j]; }
    __device__ __forceinline__ void get(f32x4 (&v)[8]) const {
#pragma unroll
        for (int j = 0; j < 8; ++j) v[j] = r[j]; } };
template <> struct RowBuf<true> { v2u r[8];
    __device__ __forceinline__ void load(const float* slot, int lane) { const GAS v2u* p = (const GAS v2u*)slot + lane;
#pragma unroll
        for (int j = 0; j < 8; ++j) r[j] = p[64 * j]; }
    __device__ __forceinline__ void get(f32x4 (&v)[8]) const {
#pragma unroll
        for (int j = 0; j < 8; ++j) { v[j].x = bf_lo(r[j].x); v[j].y = bf_hi(r[j].x); v[j].z = bf_lo(r[j].y); v[j].w = bf_hi(r[j].y); } } };
template <bool BF>
__device__ __forceinline__ void phase_norm1(const Frame& F0, KArgs a, int layer, const float* xsrc  ) { Frame F = relocal(F0);
    LAS float* wg = (LAS float*)(F.lds + RING_OFF);
    const float* WG = (const float*)(F.wsw + WS_WG) + (size_t)layer * 8 * DM;
    const float* gainp = a->in[10] + (size_t)layer * DM; const float* gb = a->in[2] + layer * 8;
    bf16* HB = (bf16*)(F.ws + WS_HB); float* GP = (float*)(F.ws + WS_GP);
    const int gw = F.vcu * NWAVES + F.wave, NGW = F.G * NWAVES;
    RowBuf<BF> ring[4];
#pragma unroll
    for (int s = 0; s < 4; ++s) ring[s].load(xsrc + (size_t)(gw + s * NGW < MG ? gw + s * NGW : gw) * DM, F.lane);
    for (int i = F.tid; i < 8 * DM / 4; i += NWAVES * 64) ((LAS f32x4*)wg)[i] = ((const GAS f32x4*)WG)[i];
    f32x4 g[8];
#pragma unroll
    for (int j = 0; j < 8; ++j) g[j] = ((const GAS f32x4*)gainp)[F.lane + 64 * j];
    const int gidx = 4 * (F.lane & 1) + 2 * ((F.lane >> 1) & 1) + ((F.lane >> 2) & 1);
    const float gbias = ((const GAS float*)gb)[gidx];
    __syncthreads();
#pragma unroll 1
    for (int m = gw; m < MG; m += 4 * NGW) {
#pragma unroll
        for (int s = 0; s < 4; s += 2) {
            const bool ok0 = m + s * NGW < MG, ok1 = m + (s + 1) * NGW < MG;
            const int m0 = ok0 ? m + s * NGW : m, m1 = ok1 ? m + (s + 1) * NGW : m;
            f32x4 x0[8], x1[8]; ring[s].get(x0); ring[s + 1].get(x1);
            const int n0 = m0 + 4 * NGW < MG ? m0 + 4 * NGW : m0, n1 = m1 + 4 * NGW < MG ? m1 + 4 * NGW : m1;
            if constexpr (BF) { ring[s].load(xsrc + (size_t)n0 * DM, F.lane); ring[s + 1].load(xsrc + (size_t)n1 * DM, F.lane); }
            rms_apply_g(g, x0); if (ok0) store_row_bf16(HB + (size_t)m0 * DM, F.lane, x0);
            if (ok0) { GAS unsigned* o8 = (GAS unsigned*)(F.ws + WS_HB8 + (size_t)m0 * DM) + F.lane;
#pragma unroll
              for (int j = 0; j < 8; ++j) o8[64 * j] = pk4_fp8(x0[j].x, x0[j].y, x0[j].z, x0[j].w); }
            rms_apply_g(g, x1); if (ok1) store_row_bf16(HB + (size_t)m1 * DM, F.lane, x1);
            if (ok1) { GAS unsigned* o8 = (GAS unsigned*)(F.ws + WS_HB8 + (size_t)m1 * DM) + F.lane;
#pragma unroll
              for (int j = 0; j < 8; ++j) o8[64 * j] = pk4_fp8(x1[j].x, x1[j].y, x1[j].z, x1[j].w); }
            float a0[8], a1[8];
#pragma unroll
            for (int q = 0; q < 8; ++q) { float s0 = 0.f, s1 = 0.f;
#pragma unroll
                for (int j = 0; j < 8; ++j) { const f32x4 w = ((const LAS f32x4*)(wg + q * DM))[F.lane + 64 * j];
                    s0 += (x0[j].x * w.x + x0[j].y * w.y) + (x0[j].z * w.z + x0[j].w * w.w);
                    s1 += (x1[j].x * w.x + x1[j].y * w.y) + (x1[j].z * w.z + x1[j].w * w.w); }
                a0[q] = s0; a1[q] = s1; asm volatile("" ::: "memory"); }
            const float r0 = reduce8(a0, F.lane), r1 = reduce8(a1, F.lane);
            if (F.lane < 8 && ok0) ((GAS float*)GP)[(size_t)m0 * 8 + gidx] = r0 + gbias;
            if (F.lane < 8 && ok1) ((GAS float*)GP)[(size_t)m1 * 8 + gidx] = r1 + gbias;
            if constexpr (!BF) { ring[s].load(xsrc + (size_t)n0 * DM, F.lane); ring[s + 1].load(xsrc + (size_t)n1 * DM, F.lane); }
        }
    }
    __syncthreads();
}
__device__ __forceinline__ void phase_norm2(const Frame& F0, KArgs a, int layer, const float* xsrc) { Frame F = relocal(F0);
    const float* gainp = a->in[11] + (size_t)layer * DM; bf16* HB = (bf16*)(F.ws + WS_HB);
    const int gw = F.vcu * NWAVES + F.wave, NGW = F.G * NWAVES;
    RowBuf<true> ring[4];
#pragma unroll
    for (int s = 0; s < 4; ++s) ring[s].load(xsrc + (size_t)(gw + s * NGW < MG ? gw + s * NGW : gw) * DM, F.lane);
    f32x4 g[8];
#pragma unroll
    for (int j = 0; j < 8; ++j) g[j] = ((const GAS f32x4*)gainp)[F.lane + 64 * j];
#pragma unroll 1
    for (int m = gw; m < MG; m += 4 * NGW) {
#pragma unroll
        for (int s = 0; s < 4; ++s) { const int mm = m + s * NGW; const bool ok = mm < MG;
            f32x4 x[8]; ring[s].get(x);
            ring[s].load(xsrc + (size_t)(mm + 4 * NGW < MG ? mm + 4 * NGW : gw) * DM, F.lane);
            rms_apply_g(g, x); if (ok) store_row_bf16(HB + (size_t)mm * DM, F.lane, x); }
    }
}
__device__ __forceinline__ void phase_final(const Frame& F0, KArgs a) { Frame F = relocal(F0);
    const float* gainp = a->in[15]; const int gw = F.vcu * NWAVES + F.wave, NGW = F.G * NWAVES;
    float* base = F.out + (size_t)F.team * GPT * MG * DM;
    constexpr int NR = GPT * MG;
    RowBuf<true> ring[4];
#pragma unroll
    for (int s = 0; s < 4; ++s) if (gw + s * NGW < NR) ring[s].load(base + (size_t)(gw + s * NGW) * DM, F.lane);
    f32x4 g[8];
#pragma unroll
    for (int j = 0; j < 8; ++j) g[j] = ((const GAS f32x4*)gainp)[F.lane + 64 * j];
#pragma unroll 1
    for (int m = gw; m < NR; m += 4 * NGW) {
#pragma unroll
        for (int s = 0; s < 4; ++s) { const int mm = m + s * NGW;
            if (mm >= NR) break;
            f32x4 x[8]; ring[s].get(x);
            if (mm + 4 * NGW < NR) ring[s].load(base + (size_t)(mm + 4 * NGW) * DM, F.lane);
            rms_apply_g(g, x);
            GAS f32x4* o = (GAS f32x4*)(base + (size_t)mm * DM) + F.lane;
#pragma unroll
            for (int j = 0; j < 8; ++j) o[64 * j] = x[j]; }
    }
}

__device__ __forceinline__ float log_sigmoid_f(float x) { return x >= 0.f ? -log1pf(expf(-x)) : x - log1pf(expf(x)); }
__device__ __forceinline__ void gate_scan(const Frame& F0, int bh) { Frame F = relocal(F0);
    const int b = bh >> 2, h = bh & 3, lane = F.lane, w = F.wave;
    const GAS float* GP = (const GAS float*)(F.ws + WS_GP) + (size_t)b * SEQ * 8;
    GAS float* A2 = (GAS float*)(F.ws + WS_A2) + (size_t)b * SEQ * 4; GAS float* NM = (GAS float*)(F.ws + WS_NM) + (size_t)b * SEQ * 4; GAS float* KSC = (GAS float*)(F.ws + WS_KSC) + (size_t)b * SEQ * 4;
    GAS float* BMAX = (GAS float*)(F.ws + WS_BMAX) + bh * 32;
    volatile LAS float* xs = (volatile LAS float*)(F.lds + RING_OFF);
    const int t0 = w * 256 + lane * 4;
    float c[4], li[4];
    float run = 0.f;
#pragma unroll
    for (int i = 0; i < 4; ++i) { li[i] = GP[(size_t)(t0 + i) * 8 + h]; run += log_sigmoid_f(GP[(size_t)(t0 + i) * 8 + 4 + h]); c[i] = run; }
    float off = 0.f, wtot;
    { float a_ = 0.f;
#pragma unroll
      for (int i = 0; i < 64; ++i) { off = (lane == i) ? a_ : off; a_ += __uint_as_float(__builtin_amdgcn_readlane(__float_as_uint(run), i)); }
      wtot = a_; }
    __syncthreads();
    if (lane == 0) xs[w] = wtot;
    __syncthreads();
#pragma unroll
    for (int i = 0; i < 8; ++i) { const float x = xs[i]; off += (i < w) ? x : 0.f; }
    float pmx = -__builtin_inff();
#pragma unroll
    for (int i = 0; i < 4; ++i) { c[i] += off; li[i] = li[i] - c[i]; pmx = fmaxf(pmx, li[i]); }
    float pre = -__builtin_inff(), wmx;
    { float a_ = -__builtin_inff();
#pragma unroll
      for (int i = 0; i < 64; ++i) { pre = (lane == i) ? a_ : pre; a_ = fmaxf(a_, __uint_as_float(__builtin_amdgcn_readlane(__float_as_uint(pmx), i))); }
      wmx = a_; }
    if (lane == 0) xs[8 + w] = wmx;
    __syncthreads();
#pragma unroll
    for (int i = 0; i < 8; ++i) { const float x = xs[8 + i]; pre = (i < w) ? fmaxf(pre, x) : pre; }
    float bmax = fmaxf(fmaxf(li[0], li[1]), fmaxf(li[2], li[3]));
    bmax = fmaxf(bmax, swz_xor<1>(bmax)); bmax = fmaxf(bmax, swz_xor<2>(bmax)); bmax = fmaxf(bmax, swz_xor<4>(bmax)); bmax = fmaxf(bmax, swz_xor<8>(bmax));
    if ((lane & 15) == 0) BMAX[w * 4 + (lane >> 4)] = bmax * LOG2E;
    float rm = pre;
#pragma unroll
    for (int i = 0; i < 4; ++i) { rm = fmaxf(rm, li[i]); const float mp = fmaxf(rm, 0.f); const size_t o = (size_t)(t0 + i) * 4 + h;
        A2[o] = -mp * LOG2E; NM[o] = expf(-(c[i] + mp)); KSC[o] = exp2f((li[i] - bmax) * LOG2E); }
    __syncthreads();
}

__device__ __forceinline__ float log2_gamma(int h) { const float x = exp2f(-5.0f - (float)h); const float x2 = x * x;
    return -(x + x2 * (0.5f + x * (1.f / 3.f) + x2 * (0.25f + x * 0.2f + x2 * (1.f / 6.f)))) * LOG2E; }
__device__ __forceinline__ void phase_prep(const Frame& F0, KArgs a, int layer) { Frame F = relocal(F0);
    bf16* PROJ = (bf16*)(F.ws + WS_PROJ);
    const int lane = F.lane;
    {
        LAS float* red = (LAS float*)(F.lds + RING_OFF);
        float* KM = (float*)(F.ws + WS_KMEAN);
        for (int task = F.vcu; task < GB * 8 * 8; task += F.G) {
            const int b = task >> 6, n = (task >> 3) & 7, h = task & 7;
            const int rg = F.tid >> 4, ch = F.tid & 15;
            float acc[8];
#pragma unroll
            for (int j = 0; j < 8; ++j) acc[j] = 0.f;
            v4u kw[8];
#pragma unroll
            for (int i = 0; i < 8; ++i) kw[i] = *(const GAS v4u*)(PROJ + (size_t)(b * SEQ + n * 256 + rg + 32 * i) * NPROJ + C_BK + h * 128 + ch * 8);
#pragma unroll
            for (int i = 0; i < 8; ++i) { const v4u w = kw[i];
                acc[0] += bf_lo(w.x); acc[1] += bf_hi(w.x); acc[2] += bf_lo(w.y); acc[3] += bf_hi(w.y); acc[4] += bf_lo(w.z); acc[5] += bf_hi(w.z); acc[6] += bf_lo(w.w); acc[7] += bf_hi(w.w); }
#pragma unroll
            for (int j = 0; j < 8; ++j) red[rg * 128 + ch * 8 + j] = acc[j];
            __syncthreads();
            if (F.tid < 128) { float s = 0.f;
#pragma unroll 8
                for (int r = 0; r < 32; ++r) s += red[r * 128 + F.tid];
                KM[(size_t)((b * 8 + h) * 8 + n) * 128 + F.tid] = s * (1.f / 256.f); }
            __syncthreads();
        }
    }
    const int gw = F.vcu * NWAVES + F.wave, NGW = F.G * NWAVES;
    {
        const float* cw = a->in[3] + (size_t)layer * 4 * 1024; const float* cb = a->in[4] + (size_t)layer * 1024;
        const float* KSC = (const float*)(F.ws + WS_KSC); bf16* MQK = (bf16*)(F.ws + WS_MQK);
        for (int task = gw; task < (MG / 16) * 2; task += NGW) {
            const int half = task & 1, row0 = (task >> 1) * 16, c0 = half * 512 + lane * 8, t0 = row0 & (SEQ - 1), hh = lane >> 4;
            float w[4][8], bias[8];
#pragma unroll
            for (int j = 0; j < 4; ++j)
#pragma unroll
                for (int e = 0; e < 8; ++e) w[j][e] = cw[j * 1024 + c0 + e];
#pragma unroll
            for (int e = 0; e < 8; ++e) bias[e] = cb[c0 + e];
            v4u xr[19];
#pragma unroll
            for (int r = 0; r < 19; ++r) { xr[r] = (v4u){0u, 0u, 0u, 0u}; if (t0 + r - 3 >= 0) xr[r] = *(const GAS v4u*)(PROJ + (size_t)(row0 + r - 3) * NPROJ + C_MQ + c0); }
            const float* kscp = KSC + (size_t)row0 * 4 + hh;
#pragma unroll
            for (int r = 0; r < 16; ++r) {
                const v4u v0 = xr[r], v1 = xr[r + 1], v2 = xr[r + 2], v3 = xr[r + 3];
                const float x0[8] = {bf_lo(v0.x), bf_hi(v0.x), bf_lo(v0.y), bf_hi(v0.y), bf_lo(v0.z), bf_hi(v0.z), bf_lo(v0.w), bf_hi(v0.w)};
                const float x1[8] = {bf_lo(v1.x), bf_hi(v1.x), bf_lo(v1.y), bf_hi(v1.y), bf_lo(v1.z), bf_hi(v1.z), bf_lo(v1.w), bf_hi(v1.w)};
                const float x2[8] = {bf_lo(v2.x), bf_hi(v2.x), bf_lo(v2.y), bf_hi(v2.y), bf_lo(v2.z), bf_hi(v2.z), bf_lo(v2.w), bf_hi(v2.w)};
                const float x3[8] = {bf_lo(v3.x), bf_hi(v3.x), bf_lo(v3.y), bf_hi(v3.y), bf_lo(v3.z), bf_hi(v3.z), bf_lo(v3.w), bf_hi(v3.w)};
                const float sc = half ? kscp[r * 4] : QSCALE;
                float y[8];
#pragma unroll
                for (int e = 0; e < 8; ++e) { const float z = bias[e] + w[0][e] * x0[e] + w[1][e] * x1[e] + w[2][e] * x2[e] + w[3][e] * x3[e]; y[e] = z * sigmoidf_fast(z) * sc; }
                v4u o; o.x = pk2(y[0], y[1]); o.y = pk2(y[2], y[3]); o.z = pk2(y[4], y[5]); o.w = pk2(y[6], y[7]);
                *(GAS v4u*)(MQK + (size_t)(row0 + r) * 1024 + c0) = o;
            }
        }
    }
}

__device__ __forceinline__ int t5_bucket(int n) { if (n < 16) return n; const int l = 16 + (int)(logf((float)n * (1.f / 16.f)) / logf(8.f) * 16.f); return l < 31 ? l : 31; }

namespace mx {
typedef short bf16x8 __attribute__((ext_vector_type(8)));
typedef short s16x4 __attribute__((ext_vector_type(4)));
typedef float f32x16 __attribute__((ext_vector_type(16)));
constexpr int VBUF = 32768, KBUF = 16384, V_OFF = 0, K_OFF = 65536, X_OFF = 98304;
constexpr int X_AL = 0, X_LI = 1024, X_SS = 2048, X_KML = 4096, X_BT = 8192, X_GT = 12288;
#define KSWZ(row, colB) ((row) * 256 + ((colB) ^ (((row) & 7) << 4)))
__device__ __forceinline__ int v_st(int k, int c) { const int kk = (k & ~0xC) | ((k & 4) << 1) | ((k & 8) >> 1); return ((kk >> 3) * 4 + (c >> 5)) * 512 + ((kk & 7) * 32 + (c & 31)) * 2; }
__device__ __forceinline__ int v_rd_base(int lane) { return ((lane & 3) << 3) | (((lane >> 2) & 3) << 6) | (((lane >> 4) & 1) << 5) | (((lane >> 5) & 1) << 8); }
constexpr int v_rd_off(int d0, int ks, int half) { return d0 * 512 + ks * 4096 + half * 2048; }
__device__ __forceinline__ int crow(int r, int hi) { return (r & 3) + 8 * (r >> 2) + 4 * hi; }
__device__ __forceinline__ unsigned cvtpk(float lo, float hi) { unsigned r; asm volatile("v_cvt_pk_bf16_f32 %0, %1, %2" : "=v"(r) : "v"(lo), "v"(hi)); return r; }
#define MX_PK4(P, B_, OUT) do { unsigned a0 = cvtpk(P[B_+0], P[B_+1]), a1 = cvtpk(P[B_+2], P[B_+3]);                          \
        unsigned b0 = cvtpk(P[B_+4], P[B_+5]), b1 = cvtpk(P[B_+6], P[B_+7]);                                             \
        auto r0 = __builtin_amdgcn_permlane32_swap(a0, b0, false, false); auto r1 = __builtin_amdgcn_permlane32_swap(a1, b1, false, false); \
        v4u w_ = {r0[0], r1[0], r0[1], r1[1]}; OUT = __builtin_bit_cast(bf16x8, w_); } while (0)
template <int KB>
__device__ __forceinline__ void qkt(f32x16& p0, f32x16& p1, LAS unsigned char* L, int r32, int hi, const bf16x8* qr) {
    p0 = f32x16{}; p1 = f32x16{};
    const LAS unsigned char* kb[4];
#pragma unroll
    for (int dd = 0; dd < 4; ++dd) kb[dd] = L + K_OFF + KB * KBUF + KSWZ(r32, (dd * 16 + hi * 8) * 2);
#pragma unroll
    for (int d0 = 0; d0 < 8; ++d0) { const LAS unsigned char* a = kb[d0 & 3] + (d0 >> 2) * 128;
        const bf16x8 b0 = *(const LAS bf16x8*)a;
        const bf16x8 b1 = *(const LAS bf16x8*)(a + 32 * 256);
        __builtin_amdgcn_s_setprio(1);
        p0 = __builtin_amdgcn_mfma_f32_32x32x16_bf16(b0, qr[d0], p0, 0, 0, 0);
        p1 = __builtin_amdgcn_mfma_f32_32x32x16_bf16(b1, qr[d0], p1, 0, 0, 0);
        __builtin_amdgcn_s_setprio(0); }
}
template <int VB>
__device__ __forceinline__ void pv_tile(f32x16* o, int vb0, bf16x8 pa0, bf16x8 pa1, bf16x8 pa2, bf16x8 pa3) {
#define MX_TRRD(dst, off) asm volatile("ds_read_b64_tr_b16 %0, %1 offset:%2" : "=&v"(dst) : "v"(vb0), "i"(off) : "memory")
#define MX_PV_D0(d0) do { s16x4 l0, l1, l2, l3, h0, h1, h2, h3; constexpr int b_ = V_OFF + VB * VBUF + v_rd_off(d0, 0, 0); \
        MX_TRRD(l0, b_); MX_TRRD(h0, b_ + 2048); MX_TRRD(l1, b_ + 4096); MX_TRRD(h1, b_ + 6144); MX_TRRD(l2, b_ + 8192); MX_TRRD(h2, b_ + 10240); MX_TRRD(l3, b_ + 12288); MX_TRRD(h3, b_ + 14336); \
        asm volatile("s_waitcnt lgkmcnt(0)" ::: "memory"); __builtin_amdgcn_sched_barrier(0); __builtin_amdgcn_s_setprio(1);   \
        o[d0] = __builtin_amdgcn_mfma_f32_32x32x16_bf16(pa0, (bf16x8){l0[0], l0[1], l0[2], l0[3], h0[0], h0[1], h0[2], h0[3]}, o[d0], 0, 0, 0);   \
        o[d0] = __builtin_amdgcn_mfma_f32_32x32x16_bf16(pa1, (bf16x8){l1[0], l1[1], l1[2], l1[3], h1[0], h1[1], h1[2], h1[3]}, o[d0], 0, 0, 0);   \
        o[d0] = __builtin_amdgcn_mfma_f32_32x32x16_bf16(pa2, (bf16x8){l2[0], l2[1], l2[2], l2[3], h2[0], h2[1], h2[2], h2[3]}, o[d0], 0, 0, 0);   \
        o[d0] = __builtin_amdgcn_mfma_f32_32x32x16_bf16(pa3, (bf16x8){l3[0], l3[1], l3[2], l3[3], h3[0], h3[1], h3[2], h3[3]}, o[d0], 0, 0, 0); __builtin_amdgcn_s_setprio(0); } while (0)
    MX_PV_D0(0); MX_PV_D0(1); MX_PV_D0(2); MX_PV_D0(3);
#undef MX_PV_D0
#undef MX_TRRD
}
struct MixArgs { unsigned char* ws; const float* rel_bias; const float* norm_w; };

template <int TYPE, bool CH = false>
__device__ __forceinline__ void mix_block(const MixArgs p, LAS unsigned char* L, int b, int h, int blk, unsigned* ctr = nullptr) {
    int tid_ = threadIdx.x; asm volatile("" : "+v"(tid_));
    const int tid = tid_, wid = __builtin_amdgcn_readfirstlane(tid >> 6), lane = tid & 63, r32 = lane & 31, hi = lane >> 5;
    constexpr int QROWS = (TYPE == 1) ? 128 : 256, HD = (TYPE == 1) ? 256 : 128;
    const int P0 = blk * QROWS, wrow = (TYPE == 1) ? (wid & 3) : wid, vhalf = (TYPE == 1) ? (wid >> 2) : 0;
    const int qlo = P0 + 32 * wrow, trow = qlo + r32;
    const size_t grow = (size_t)b * SEQ + trow;
    const bf16* PROJ = (const bf16*)(p.ws + WS_PROJ); const bf16* MQK = (const bf16*)(p.ws + WS_MQK);
    const bf16 *Qp, *Kp, *Vp; int ldq;
    if (TYPE == 0) { Qp = PROJ + C_RQ + h * 128; Kp = PROJ + C_RK + h * 128; Vp = PROJ + C_RV + h * 128; ldq = NPROJ; }
    else if (TYPE == 1) { Qp = MQK + h * 128; Kp = MQK + 512 + h * 128; Vp = PROJ + C_MV + h * 256; ldq = 1024; }
    else { Qp = PROJ + C_BQ + h * 128; Kp = PROJ + C_BK + h * 128; Vp = PROJ + C_BV + h * 128; ldq = NPROJ; }
    const int NT = (P0 + QROWS) / 64;
    bf16x8 qr[8];
#pragma unroll
    for (int d0 = 0; d0 < 8; ++d0) qr[d0] = *(const GAS bf16x8*)(Qp + grow * ldq + d0 * 16 + hi * 8);
    const int sr = tid >> 4, sc = (tid & 15) * 8, kws = KSWZ(sr, sc * 2), vst0 = v_st(sr, sc), vst1 = v_st(32 + sr, sc);
    const bf16* kg = Kp + ((size_t)b * SEQ + sr) * ldq + sc; const bf16* vg = Vp + ((size_t)b * SEQ + sr) * NPROJ + sc;
    v4u st_k0, st_k1, st_v0, st_v1, st_v2, st_v3;
#define MX_LOAD(kb_) do { st_k0 = *(const GAS v4u*)(kg + (size_t)(kb_) * ldq); st_k1 = *(const GAS v4u*)(kg + (size_t)((kb_) + 32) * ldq); \
        st_v0 = *(const GAS v4u*)(vg + (size_t)(kb_) * NPROJ); st_v1 = *(const GAS v4u*)(vg + (size_t)((kb_) + 32) * NPROJ); \
        if (TYPE == 1) { st_v2 = *(const GAS v4u*)(vg + (size_t)(kb_) * NPROJ + 128); st_v3 = *(const GAS v4u*)(vg + (size_t)((kb_) + 32) * NPROJ + 128); } } while (0)
#define MX_WRITE(bf) do { *(LAS v4u*)(L + K_OFF + (bf) * KBUF + kws) = st_k0; *(LAS v4u*)(L + K_OFF + (bf) * KBUF + kws + 32 * 256) = st_k1; \
        *(LAS v4u*)(L + V_OFF + (bf) * VBUF + vst0) = st_v0; *(LAS v4u*)(L + V_OFF + (bf) * VBUF + vst1) = st_v1; \
        if (TYPE == 1) { *(LAS v4u*)(L + V_OFF + (bf) * VBUF + 16384 + vst0) = st_v2; *(LAS v4u*)(L + V_OFF + (bf) * VBUF + 16384 + vst1) = st_v3; } } while (0)
    if (!CH) MX_LOAD(0);
    LAS float* al_l = (LAS float*)(L + X_OFF + X_AL) + wid * 32; LAS float* li_l = (LAS float*)(L + X_OFF + X_LI) + wid * 32;
    LAS float* kml = (LAS float*)(L + X_OFF + X_KML); LAS float* btab = (LAS float*)(L + X_OFF + X_BT);
    const int own = blk;
    if (TYPE == 2) {
        const float* KM = (const float*)(p.ws + WS_KMEAN) + (size_t)(b * 8 + h) * 8 * 128;
        for (int i = tid; i < own * 128; i += NWAVES * 64) kml[i] = KM[i];
        if (tid <= 128) btab[tid] = p.rel_bias[t5_bucket(tid) * 8 + h] * LOG2E;
    }
    float rowA = 0.f, l2g = 0.f;
    if (TYPE == 0) l2g = log2_gamma(h);
    if (TYPE == 1) rowA = ((const float*)(p.ws + WS_A2))[grow * 4 + h];
    const float* BMX = (const float*)(p.ws + WS_BMAX) + (b * 4 + h) * 32;
    if (!CH) { VM_WAIT(); MX_WRITE(0); }
    if (!CH) __syncthreads();
    unsigned selmask = 0u;
    if (TYPE == 2) {
        if (own <= 3) selmask = (1u << own) - 1u;
        else {
            LAS float* gt = (LAS float*)(L + X_OFF + X_GT) + (wid * 32 + r32) * 8;
#pragma unroll 1
            for (int n = 0; n < own; ++n) { float s = 0.f;
#pragma unroll
                for (int d0 = 0; d0 < 8; ++d0) { const f32x4 k0 = *(const LAS f32x4*)(kml + n * 128 + d0 * 16 + hi * 8), k1 = *(const LAS f32x4*)(kml + n * 128 + d0 * 16 + hi * 8 + 4);
                    const v4u qw = __builtin_bit_cast(v4u, qr[d0]);
                    s += bf_lo(qw.x) * k0.x + bf_hi(qw.x) * k0.y + bf_lo(qw.y) * k0.z + bf_hi(qw.y) * k0.w + bf_lo(qw.z) * k1.x + bf_hi(qw.z) * k1.y + bf_lo(qw.w) * k1.z + bf_hi(qw.w) * k1.w; }
                s = sum_xor32(s);
                if (hi == 0) gt[n] = s; }
            asm volatile("s_waitcnt lgkmcnt(0)" ::: "memory");
            float gate[8];
            { const f32x4 g0 = *(const LAS f32x4*)gt, g1 = *(const LAS f32x4*)(gt + 4);
              gate[0] = g0.x; gate[1] = g0.y; gate[2] = g0.z; gate[3] = g0.w; gate[4] = g1.x; gate[5] = g1.y; gate[6] = g1.z; gate[7] = g1.w; }
#pragma unroll
            for (int n = 0; n < 8; ++n) if (n >= own) gate[n] = -__builtin_inff();
#pragma unroll
            for (int n = 0; n < 8; ++n) { int rank = 0;
#pragma unroll
                for (int j = 0; j < 8; ++j) rank += (gate[j] > gate[n] || (gate[j] == gate[n] && j < n)) ? 1 : 0;
                if (n < own && rank < 3) selmask |= (1u << n); }
        }
    }
    const int vb0 = (int)(unsigned)(size_t)(L + vhalf * 16384) + v_rd_base(lane);
    f32x16 o[4] = {};
    float den = 0.f, m_reg = -1e30f, l_reg = 0.f;
    if (CH) {
        MX_LOAD(2 * blk * 64);
        if (blk > 0) {
            if (tid == 0) { unsigned sp = 0; while (__hip_atomic_load(ctr, __ATOMIC_RELAXED, __HIP_MEMORY_SCOPE_AGENT) < (unsigned)blk) { __builtin_amdgcn_s_sleep(2); if (++sp > (1u << 24)) break; }
                __builtin_amdgcn_fence(__ATOMIC_ACQUIRE, "agent"); asm volatile("s_waitcnt vmcnt(0)" ::: "memory"); }
            __syncthreads();
            const bf16* img = (const bf16*)(p.ws + WS_MST_IMG) + ((size_t)(h * 16 + blk) * 128 + sr) * 256 + sc;
#pragma unroll
            for (int tau = 0; tau < 2; ++tau) {
                const v4u t0 = *(const GAS v4u*)(img + (size_t)(64 * tau) * 256), t1 = *(const GAS v4u*)(img + (size_t)(64 * tau + 32) * 256);
                const v4u t2 = *(const GAS v4u*)(img + (size_t)(64 * tau) * 256 + 128), t3 = *(const GAS v4u*)(img + (size_t)(64 * tau + 32) * 256 + 128);
                *(LAS v4u*)(L + V_OFF + tau * VBUF + vst0) = t0; *(LAS v4u*)(L + V_OFF + tau * VBUF + vst1) = t1;
                *(LAS v4u*)(L + V_OFF + tau * VBUF + 16384 + vst0) = t2; *(LAS v4u*)(L + V_OFF + tau * VBUF + 16384 + vst1) = t3; }
            if (tid < 128) kml[tid] = ((const float*)(p.ws + WS_MST_Z))[(h * 16 + blk) * 128 + tid];
            const float Rref = ((const float*)(p.ws + WS_MST_R))[h * 16 + blk];
            const float fac = __builtin_amdgcn_exp2f(rowA + Rref);
            if (hi == 0) al_l[r32] = fac;
            __syncthreads();
            pv_tile<0>(o, vb0, qr[0], qr[1], qr[2], qr[3]);
            pv_tile<1>(o, vb0, qr[4], qr[5], qr[6], qr[7]);
            float dz = 0.f;
#pragma unroll
            for (int d0 = 0; d0 < 8; ++d0) { const f32x4 z0 = *(const LAS f32x4*)(kml + d0 * 16 + hi * 8), z1 = *(const LAS f32x4*)(kml + d0 * 16 + hi * 8 + 4);
                const v4u qw = __builtin_bit_cast(v4u, qr[d0]);
                dz += bf_lo(qw.x) * z0.x + bf_hi(qw.x) * z0.y + bf_lo(qw.y) * z0.z + bf_hi(qw.y) * z0.w + bf_lo(qw.z) * z1.x + bf_hi(qw.z) * z1.y + bf_lo(qw.w) * z1.z + bf_hi(qw.w) * z1.w; }
            den = dz * fac;
            asm volatile("s_waitcnt lgkmcnt(0)" ::: "memory");
#pragma unroll
            for (int r = 0; r < 16; ++r) { const float a_ = al_l[crow(r, hi)]; o[0][r] *= a_; o[1][r] *= a_; o[2][r] *= a_; o[3][r] *= a_; }
            __syncthreads();
        }
        VM_WAIT(); MX_WRITE(0);
        __syncthreads();
    }
    const float b31 = (TYPE == 2) ? btab[128] : 0.f;
    constexpr float C2 = QSCALE * LOG2E, THR = 8.f;
#define MX_STEP(t_, KB) do { const int t = (t_), kb = t * 64; \
        if (t + 1 < NT) MX_LOAD(kb + 64); \
        if (kb <= qlo + 31) { \
            f32x16 p0, p1; qkt<KB>(p0, p1, L, r32, hi, qr); \
            const int dq = trow - kb - 4 * hi;                         \
            const bool diag = kb + 63 > qlo; \
            bf16x8 pa0, pa1, pa2, pa3; \
            if (TYPE != 2) { \
                const float rf = (TYPE == 0) ? __builtin_amdgcn_exp2f((float)(trow - kb) * l2g) : __builtin_amdgcn_exp2f(rowA + BMX[t]); \
                if (diag) { _Pragma("unroll") for (int r = 0; r < 16; ++r) { const int c = (r & 3) + 8 * (r >> 2); p0[r] = (c <= dq) ? p0[r] * rf : 0.f; p1[r] = (c + 32 <= dq) ? p1[r] * rf : 0.f; } } \
                else { _Pragma("unroll") for (int r = 0; r < 16; ++r) { p0[r] *= rf; p1[r] *= rf; } } \
                if (TYPE == 1) { float ps = 0.f; _Pragma("unroll") for (int r = 0; r < 16; ++r) ps += p0[r] + p1[r]; den += ps; } \
            } else { \
                const int kblk = kb >> 8; const bool lane_ok = (kblk == own) || ((selmask >> kblk) & 1u); \
                const float NEG = -__builtin_inff(); \
                if (qlo - (kb + 63) < 128) { _Pragma("unroll") for (int r = 0; r < 16; ++r) { const int c = (r & 3) + 8 * (r >> 2); const int d0_ = dq - c, d1_ = dq - c - 32; \
                        const float x0 = fmaf(p0[r], C2, btab[d0_ < 0 ? 0 : (d0_ > 128 ? 128 : d0_)]), x1 = fmaf(p1[r], C2, btab[d1_ < 0 ? 0 : (d1_ > 128 ? 128 : d1_)]); \
                        p0[r] = (lane_ok && d0_ >= 0) ? x0 : NEG; p1[r] = (lane_ok && d1_ >= 0) ? x1 : NEG; if ((r & 3) == 3) asm volatile("" ::: "memory"); } } \
                else { _Pragma("unroll") for (int r = 0; r < 16; ++r) { p0[r] = lane_ok ? fmaf(p0[r], C2, b31) : NEG; p1[r] = lane_ok ? fmaf(p1[r], C2, b31) : NEG; } } \
                float pmax = p0[0]; _Pragma("unroll") for (int r = 1; r < 16; ++r) pmax = fmaxf(pmax, p0[r]); _Pragma("unroll") for (int r = 0; r < 16; ++r) pmax = fmaxf(pmax, p1[r]); \
                pmax = max_xor32(pmax); \
                float mn, alpha; \
                if (__all(pmax - m_reg <= THR)) { mn = m_reg; alpha = 1.f; } else { mn = fmaxf(m_reg, pmax); alpha = __builtin_amdgcn_exp2f(m_reg - mn); m_reg = mn; } \
                float ps = 0.f; _Pragma("unroll") for (int r = 0; r < 16; ++r) { p0[r] = __builtin_amdgcn_exp2f(p0[r] - mn); p1[r] = __builtin_amdgcn_exp2f(p1[r] - mn); ps += p0[r] + p1[r]; } \
                l_reg = l_reg * alpha + ps; \
                if (__any(alpha < 1.f)) { if (hi == 0) al_l[r32] = alpha; asm volatile("s_waitcnt lgkmcnt(0)" ::: "memory"); \
                    _Pragma("unroll") for (int r = 0; r < 16; ++r) { const float a_ = al_l[crow(r, hi)]; o[0][r] *= a_; o[1][r] *= a_; o[2][r] *= a_; o[3][r] *= a_; } } \
            } \
            MX_PK4(p0, 0, pa0); MX_PK4(p0, 8, pa1); MX_PK4(p1, 0, pa2); MX_PK4(p1, 8, pa3); \
            pv_tile<KB>(o, vb0, pa0, pa1, pa2, pa3); \
        } \
        if (t + 1 < NT) { VM_WAIT(); MX_WRITE((KB) ^ 1); } \
        __syncthreads(); } while (0)
#pragma unroll 1
    for (int tt = CH ? 2 * blk : 0; tt < NT; tt += 2) { MX_STEP(tt, 0); MX_STEP(tt + 1, 1); }
#undef MX_STEP
#undef MX_LOAD
#undef MX_WRITE
    float rs[16];
    if (TYPE == 2) {
        const float lt = sum_xor32(l_reg);
        if (hi == 0) li_l[r32] = 1.0f / lt; asm volatile("s_waitcnt lgkmcnt(0)" ::: "memory");
#pragma unroll
        for (int r = 0; r < 16; ++r) rs[r] = li_l[crow(r, hi)];
    } else {
        float pre[16];
        if (TYPE == 1) { const float dt = sum_xor32(den); const float nm = ((const float*)(p.ws + WS_NM))[grow * 4 + h];
            if (hi == 0) li_l[r32] = 1.0f / fmaxf(fabsf(dt), nm); asm volatile("s_waitcnt lgkmcnt(0)" ::: "memory");
#pragma unroll
            for (int r = 0; r < 16; ++r) pre[r] = li_l[crow(r, hi)]; }
        else {
#pragma unroll
            for (int r = 0; r < 16; ++r) pre[r] = 1.f; }
        float ss[16];
#pragma unroll
        for (int r = 0; r < 16; ++r) { const float a0 = o[0][r] * pre[r], a1 = o[1][r] * pre[r], a2 = o[2][r] * pre[r], a3 = o[3][r] * pre[r]; ss[r] = (a0 * a0 + a1 * a1) + (a2 * a2 + a3 * a3); }
#pragma unroll
        for (int r = 0; r < 16; ++r) { float v = ss[r]; v += swz_xor<1>(v); v += swz_xor<2>(v); v += swz_xor<4>(v); v += swz_xor<8>(v); v += swz_xor<16>(v); ss[r] = v; }
        if (TYPE == 1) {
            LAS float* ssx = (LAS float*)(L + X_OFF + X_SS);
            if (r32 == 0) {
#pragma unroll
                for (int r = 0; r < 16; ++r) ssx[wid * 32 + crow(r, hi)] = ss[r]; }
            __syncthreads();
#pragma unroll
            for (int r = 0; r < 16; ++r) ss[r] += ssx[(wid ^ 4) * 32 + crow(r, hi)];
        }
#pragma unroll
        for (int r = 0; r < 16; ++r) rs[r] = pre[r] / sqrtf(ss[r] * (1.f / HD) + EPS);
    }
    LAS unsigned short* stg = (LAS unsigned short*)(L + wid * 8192);
#pragma unroll
    for (int r = 0; r < 16; ++r) { const int q = crow(r, hi);
#pragma unroll
        for (int d0 = 0; d0 < 4; ++d0) stg[q * 128 + d0 * 32 + r32] = (unsigned short)f2bf(o[d0][r] * rs[r]); }
    asm volatile("s_waitcnt lgkmcnt(0)" ::: "memory");
    bf16* Y = (bf16*)(p.ws + WS_Y) + (size_t)TYPE * MG * 1024;
#pragma unroll
    for (int i = 0; i < 8; ++i) { const int rw = i * 4 + (lane >> 4), ch = lane & 15; const size_t gr = (size_t)b * SEQ + qlo + rw;
        const v4u v = *(const LAS v4u*)(stg + rw * 128 + ch * 8);
        const int col = h * HD + vhalf * 128 + ch * 8;
        if (TYPE == 2) { v2u o8; o8.x = pk4_fp8(bf_lo(v.x), bf_hi(v.x), bf_lo(v.y), bf_hi(v.y)); o8.y = pk4_fp8(bf_lo(v.z), bf_hi(v.z), bf_lo(v.w), bf_hi(v.w));
            *(GAS v2u*)((GAS unsigned char*)Y + gr * 1024 + col) = o8; }
        else { const v4u g = *(const GAS v4u*)(PROJ + gr * NPROJ + (TYPE == 0 ? C_RG : C_MO) + col);
            float e[8] = {bf_lo(v.x) * bf_lo(g.x), bf_hi(v.x) * bf_hi(g.x), bf_lo(v.y) * bf_lo(g.y), bf_hi(v.y) * bf_hi(g.y), bf_lo(v.z) * bf_lo(g.z), bf_hi(v.z) * bf_hi(g.z), bf_lo(v.w) * bf_lo(g.w), bf_hi(v.w) * bf_hi(g.w)};
            if (TYPE == 1) { const f32x4 n0 = *(const GAS f32x4*)(p.norm_w + col), n1 = *(const GAS f32x4*)(p.norm_w + col + 4);
                e[0] *= n0.x; e[1] *= n0.y; e[2] *= n0.z; e[3] *= n0.w; e[4] *= n1.x; e[5] *= n1.y; e[6] *= n1.z; e[7] *= n1.w; }
            v4u ow; ow.x = pk2(e[0], e[1]); ow.y = pk2(e[2], e[3]); ow.z = pk2(e[4], e[5]); ow.w = pk2(e[6], e[7]);
            *(GAS v4u*)(Y + gr * 1024 + col) = ow; }
    }
    __syncthreads();
}

__device__ __forceinline__ void mix_ret_chain(const MixArgs p, LAS unsigned char* L, int b, int h) {
    int tid0_ = threadIdx.x; asm volatile("" : "+v"(tid0_));
    const int wid = __builtin_amdgcn_readfirstlane(tid0_ >> 6);
    v4u st_k0, st_k1, st_v0, st_v1;
#define RC_LOAD(kb_) do { st_k0 = *(const GAS v4u*)(kg + (size_t)(kb_) * NPROJ); st_k1 = *(const GAS v4u*)(kg + (size_t)((kb_) + 32) * NPROJ); \
        st_v0 = *(const GAS v4u*)(vg + (size_t)(kb_) * NPROJ); st_v1 = *(const GAS v4u*)(vg + (size_t)((kb_) + 32) * NPROJ); } while (0)
#define RC_WRITE(bf) do { *(LAS v4u*)(L + K_OFF + (bf) * KBUF + kws) = st_k0; *(LAS v4u*)(L + K_OFF + (bf) * KBUF + kws + 32 * 256) = st_k1; \
        *(LAS v4u*)(L + V_OFF + (bf) * VBUF + vst0) = st_v0; *(LAS v4u*)(L + V_OFF + (bf) * VBUF + vst1) = st_v1; } while (0)
    const float l2g = log2_gamma(h), g64 = exp2f(64.f * l2g);
    const int ti = wid >> 1, tj = 2 * (wid & 1);
#define RC_TRRD(dst, base, off) asm volatile("ds_read_b64_tr_b16 %0, %1 offset:%2" : "=&v"(dst) : "v"(base), "i"(off) : "memory")
#define RC_STATE(KB) do { _Pragma("unroll") for (int ks = 0; ks < 4; ++ks) { s16x4 a0, a1, l0, h0, l1, h1; \
            RC_TRRD(a0, ka[0], (KB) * KBUF + ks * 4096); RC_TRRD(a1, ka[1], (KB) * KBUF + ks * 4096); \
            if (tj == 0) { RC_TRRD(l0, vb0, V_OFF + (KB) * VBUF + v_rd_off(0, 0, 0) + ks * 4096); RC_TRRD(h0, vb0, V_OFF + (KB) * VBUF + v_rd_off(0, 0, 0) + ks * 4096 + 2048); \
                           RC_TRRD(l1, vb0, V_OFF + (KB) * VBUF + v_rd_off(1, 0, 0) + ks * 4096); RC_TRRD(h1, vb0, V_OFF + (KB) * VBUF + v_rd_off(1, 0, 0) + ks * 4096 + 2048); } \
            else         { RC_TRRD(l0, vb0, V_OFF + (KB) * VBUF + v_rd_off(2, 0, 0) + ks * 4096); RC_TRRD(h0, vb0, V_OFF + (KB) * VBUF + v_rd_off(2, 0, 0) + ks * 4096 + 2048); \
                           RC_TRRD(l1, vb0, V_OFF + (KB) * VBUF + v_rd_off(3, 0, 0) + ks * 4096); RC_TRRD(h1, vb0, V_OFF + (KB) * VBUF + v_rd_off(3, 0, 0) + ks * 4096 + 2048); } \
            asm volatile("s_waitcnt lgkmcnt(0)" ::: "memory"); __builtin_amdgcn_sched_barrier(0); \
            const bf16x8 af = (bf16x8){a0[0], a0[1], a0[2], a0[3], a1[0], a1[1], a1[2], a1[3]}; \
            tt0 = __builtin_amdgcn_mfma_f32_32x32x16_bf16(af, (bf16x8){l0[0], l0[1], l0[2], l0[3], h0[0], h0[1], h0[2], h0[3]}, tt0, 0, 0, 0); \
            tt1 = __builtin_amdgcn_mfma_f32_32x32x16_bf16(af, (bf16x8){l1[0], l1[1], l1[2], l1[3], h1[0], h1[1], h1[2], h1[3]}, tt1, 0, 0, 0); } \
        _Pragma("unroll") for (int r = 0; r < 16; ++r) { tt0[r] *= g64; tt1[r] *= g64; } } while (0)
    f32x16 tt0 = {}, tt1 = {};
#pragma unroll 1
    for (int c = 0; c < 8; ++c) {
        int tid_ = tid0_; asm volatile("" : "+v"(tid_));
        const int tid = tid_, lane = tid & 63, r32 = lane & 31, hi = lane >> 5;
        const bf16* PROJ = (const bf16*)(p.ws + WS_PROJ);
        const bf16* Qp = PROJ + C_RQ + h * 128; const bf16* Kp = PROJ + C_RK + h * 128; const bf16* Vp = PROJ + C_RV + h * 128;
        const int sr = tid >> 4, sc = (tid & 15) * 8, kws = KSWZ(sr, sc * 2), vst0 = v_st(sr, sc), vst1 = v_st(32 + sr, sc);
        const bf16* kg = Kp + ((size_t)b * SEQ + sr) * NPROJ + sc; const bf16* vg = Vp + ((size_t)b * SEQ + sr) * NPROJ + sc;
        LAS float* al_l = (LAS float*)(L + X_OFF + X_AL) + wid * 32;
        const int vb0 = (int)(unsigned)(size_t)L + v_rd_base(lane), vbT = vb0 + 16384;
        int ka[2];
#pragma unroll
        for (int u = 0; u < 2; ++u) { const int q = lane & 15, G = lane >> 4, row = 8 * (G >> 1) + 4 * u + (q >> 2), colB = 2 * (32 * ti + 16 * (G & 1) + 4 * (q & 3));
            ka[u] = (int)(unsigned)(size_t)(L + K_OFF) + KSWZ(row, colB); }
        const int P0 = c * 256, qlo = P0 + 32 * wid, trow = qlo + r32;
        const size_t grow = (size_t)b * SEQ + trow;
        bf16x8 qr[8];
#pragma unroll
        for (int d0 = 0; d0 < 8; ++d0) qr[d0] = *(const GAS bf16x8*)(Qp + grow * NPROJ + d0 * 16 + hi * 8);
        RC_LOAD(P0);
        f32x16 o[4] = {};
        if (c > 0) {
            if (hi == 0) al_l[r32] = __builtin_amdgcn_exp2f((float)(32 * wid + r32) * l2g);
            pv_tile<0>(o, vbT, qr[0], qr[1], qr[2], qr[3]);
            pv_tile<1>(o, vbT, qr[4], qr[5], qr[6], qr[7]);
            asm volatile("s_waitcnt lgkmcnt(0)" ::: "memory");
#pragma unroll
            for (int r = 0; r < 16; ++r) { const float a_ = al_l[crow(r, hi)]; o[0][r] *= a_; o[1][r] *= a_; o[2][r] *= a_; o[3][r] *= a_; }
        }
        VM_WAIT(); RC_WRITE(0);
        __syncthreads();
#define RC_STEP(j_, KB) do { const int kb = P0 + 64 * (j_); \
        if ((j_) < 3) RC_LOAD(kb + 64); \
        if (kb <= qlo + 31) { \
            f32x16 p0, p1; qkt<KB>(p0, p1, L, r32, hi, qr); \
            const int dq = trow - kb - 4 * hi; \
            const bool diag = kb + 63 > qlo; \
            bf16x8 pa0, pa1, pa2, pa3; \
            const float rf = __builtin_amdgcn_exp2f((float)(trow - kb) * l2g); \
            if (diag) { _Pragma("unroll") for (int r = 0; r < 16; ++r) { const int cc = (r & 3) + 8 * (r >> 2); p0[r] = (cc <= dq) ? p0[r] * rf : 0.f; p1[r] = (cc + 32 <= dq) ? p1[r] * rf : 0.f; } } \
            else { _Pragma("unroll") for (int r = 0; r < 16; ++r) { p0[r] *= rf; p1[r] *= rf; } } \
            MX_PK4(p0, 0, pa0); MX_PK4(p0, 8, pa1); MX_PK4(p1, 0, pa2); MX_PK4(p1, 8, pa3); \
            pv_tile<KB>(o, vb0, pa0, pa1, pa2, pa3); \
        } \
        if (c < 7) RC_STATE(KB); \
        if ((j_) < 3) { VM_WAIT(); RC_WRITE((KB) ^ 1); } \
        __syncthreads(); } while (0)
        RC_STEP(0, 0); RC_STEP(1, 1); RC_STEP(2, 0); RC_STEP(3, 1);
#undef RC_STEP
        float rs[16];
        { float ss[16];
#pragma unroll
          for (int r = 0; r < 16; ++r) { const float a0 = o[0][r], a1 = o[1][r], a2 = o[2][r], a3 = o[3][r]; ss[r] = (a0 * a0 + a1 * a1) + (a2 * a2 + a3 * a3); }
#pragma unroll
          for (int r = 0; r < 16; ++r) { float v = ss[r]; v += swz_xor<1>(v); v += swz_xor<2>(v); v += swz_xor<4>(v); v += swz_xor<8>(v); v += swz_xor<16>(v); ss[r] = v; }
#pragma unroll
          for (int r = 0; r < 16; ++r) rs[r] = 1.0f / sqrtf(ss[r] * (1.f / 128.f) + EPS); }
        LAS unsigned short* stg = (LAS unsigned short*)(L + wid * 8192);
#pragma unroll
        for (int r = 0; r < 16; ++r) { const int q = crow(r, hi);
#pragma unroll
            for (int d0 = 0; d0 < 4; ++d0) stg[q * 128 + d0 * 32 + r32] = (unsigned short)f2bf(o[d0][r] * rs[r]); }
        asm volatile("s_waitcnt lgkmcnt(0)" ::: "memory");
        bf16* Y = (bf16*)(p.ws + WS_Y);
#pragma unroll
        for (int i = 0; i < 8; ++i) { const int rw = i * 4 + (lane >> 4), ch = lane & 15; const size_t gr = (size_t)b * SEQ + qlo + rw;
            const v4u v = *(const LAS v4u*)(stg + rw * 128 + ch * 8);
            const int col = h * 128 + ch * 8;
            const v4u g = *(const GAS v4u*)(PROJ + gr * NPROJ + C_RG + col);
            float e[8] = {bf_lo(v.x) * bf_lo(g.x), bf_hi(v.x) * bf_hi(g.x), bf_lo(v.y) * bf_lo(g.y), bf_hi(v.y) * bf_hi(g.y), bf_lo(v.z) * bf_lo(g.z), bf_hi(v.z) * bf_hi(g.z), bf_lo(v.w) * bf_lo(g.w), bf_hi(v.w) * bf_hi(g.w)};
            v4u ow; ow.x = pk2(e[0], e[1]); ow.y = pk2(e[2], e[3]); ow.z = pk2(e[4], e[5]); ow.w = pk2(e[6], e[7]);
            *(GAS v4u*)(Y + gr * 1024 + col) = ow; }
        __syncthreads();
        if (c < 7) {
#pragma unroll
            for (int r = 0; r < 16; ++r) { const int d = 32 * ti + crow(r, hi);
                LAS unsigned char* tb = L + V_OFF + (d >> 6) * VBUF + 16384;
                *(LAS unsigned short*)(tb + v_st(d & 63, 32 * tj + r32)) = (unsigned short)f2bf(tt0[r]);
                *(LAS unsigned short*)(tb + v_st(d & 63, 32 * (tj + 1) + r32)) = (unsigned short)f2bf(tt1[r]); }
            __syncthreads();
        }
    }
#undef RC_LOAD
#undef RC_WRITE
#undef RC_TRRD
#undef RC_STATE
}

__device__ __forceinline__ s16x4 scale4(s16x4 x, float s) {
    const v2u w = __builtin_bit_cast(v2u, x);
    v2u o; o.x = cvtpk(bf_lo(w.x) * s, bf_hi(w.x) * s); o.y = cvtpk(bf_lo(w.y) * s, bf_hi(w.y) * s);
    return __builtin_bit_cast(s16x4, o);
}
__device__ __forceinline__ void mlstm_state_job(const MixArgs p, LAS unsigned char* L, int b, int h, unsigned* ctr) {
    int tid0_ = threadIdx.x; asm volatile("" : "+v"(tid0_));
    const int wid = __builtin_amdgcn_readfirstlane(tid0_ >> 6);
    const int ti = wid >> 1, vh = wid & 1;
    f32x16 t0 = {}, t1 = {}, t2 = {}, t3 = {}, zz = {};
    float R = -__builtin_inff();
    const float* BMX = (const float*)(p.ws + WS_BMAX) + (b * 4 + h) * 32;
    v4u st_k0, st_k1, st_v0, st_v1, st_v2, st_v3;
#define SJ_TRRD(dst, base, off) asm volatile("ds_read_b64_tr_b16 %0, %1 offset:%2" : "=&v"(dst) : "v"(base), "i"(off) : "memory")
#define SJ_LOAD(kb_) do { st_k0 = *(const GAS v4u*)(kg + (size_t)(kb_) * 1024); st_k1 = *(const GAS v4u*)(kg + (size_t)((kb_) + 32) * 1024); \
        st_v0 = *(const GAS v4u*)(vg + (size_t)(kb_) * NPROJ); st_v1 = *(const GAS v4u*)(vg + (size_t)((kb_) + 32) * NPROJ); \
        st_v2 = *(const GAS v4u*)(vg + (size_t)(kb_) * NPROJ + 128); st_v3 = *(const GAS v4u*)(vg + (size_t)((kb_) + 32) * NPROJ + 128); } while (0)
#define SJ_WRITE(bf) do { *(LAS v4u*)(L + K_OFF + (bf) * KBUF + kws) = st_k0; *(LAS v4u*)(L + K_OFF + (bf) * KBUF + kws + 32 * 256) = st_k1; \
        *(LAS v4u*)(L + V_OFF + (bf) * VBUF + vst0) = st_v0; *(LAS v4u*)(L + V_OFF + (bf) * VBUF + vst1) = st_v1; \
        *(LAS v4u*)(L + V_OFF + (bf) * VBUF + 16384 + vst0) = st_v2; *(LAS v4u*)(L + V_OFF + (bf) * VBUF + 16384 + vst1) = st_v3; } while (0)
#define SJ_VF(d0_, KB, ks_) (bf16x8){l##d0_[0], l##d0_[1], l##d0_[2], l##d0_[3], g##d0_[0], g##d0_[1], g##d0_[2], g##d0_[3]}
#define SJ_TILE(KB, bt_) do { const float bt = (bt_); _Pragma("unroll") for (int ks = 0; ks < 4; ++ks) { s16x4 a0, a1, l0, g0, l1, g1, l2, g2, l3, g3; \
            SJ_TRRD(a0, ka[0], (KB) * KBUF + ks * 4096); SJ_TRRD(a1, ka[1], (KB) * KBUF + ks * 4096); \
            SJ_TRRD(l0, vbh, V_OFF + (KB) * VBUF + 0 * 512 + ks * 4096); SJ_TRRD(g0, vbh, V_OFF + (KB) * VBUF + 0 * 512 + ks * 4096 + 2048); \
            SJ_TRRD(l1, vbh, V_OFF + (KB) * VBUF + 1 * 512 + ks * 4096); SJ_TRRD(g1, vbh, V_OFF + (KB) * VBUF + 1 * 512 + ks * 4096 + 2048); \
            SJ_TRRD(l2, vbh, V_OFF + (KB) * VBUF + 2 * 512 + ks * 4096); SJ_TRRD(g2, vbh, V_OFF + (KB) * VBUF + 2 * 512 + ks * 4096 + 2048); \
            SJ_TRRD(l3, vbh, V_OFF + (KB) * VBUF + 3 * 512 + ks * 4096); SJ_TRRD(g3, vbh, V_OFF + (KB) * VBUF + 3 * 512 + ks * 4096 + 2048); \
            asm volatile("s_waitcnt lgkmcnt(0)" ::: "memory"); __builtin_amdgcn_sched_barrier(0); \
            a0 = scale4(a0, bt); a1 = scale4(a1, bt); \
            const bf16x8 af = (bf16x8){a0[0], a0[1], a0[2], a0[3], a1[0], a1[1], a1[2], a1[3]}; \
            t0 = __builtin_amdgcn_mfma_f32_32x32x16_bf16(af, SJ_VF(0, KB, ks), t0, 0, 0, 0); \
            t1 = __builtin_amdgcn_mfma_f32_32x32x16_bf16(af, SJ_VF(1, KB, ks), t1, 0, 0, 0); \
            t2 = __builtin_amdgcn_mfma_f32_32x32x16_bf16(af, SJ_VF(2, KB, ks), t2, 0, 0, 0); \
            t3 = __builtin_amdgcn_mfma_f32_32x32x16_bf16(af, SJ_VF(3, KB, ks), t3, 0, 0, 0); \
            if (vh == 0) zz = __builtin_amdgcn_mfma_f32_32x32x16_bf16(af, ones, zz, 0, 0, 0); } } while (0)
#pragma unroll 1
    for (int c = 0; c < 15; ++c) {
        int tid_ = tid0_; asm volatile("" : "+v"(tid_));
        const int tid = tid_, lane = tid & 63, r32 = lane & 31, hi = lane >> 5;
        const bf16* MQK = (const bf16*)(p.ws + WS_MQK); const bf16* PROJ = (const bf16*)(p.ws + WS_PROJ);
        const int sr = tid >> 4, sc = (tid & 15) * 8, kws = KSWZ(sr, sc * 2), vst0 = v_st(sr, sc), vst1 = v_st(32 + sr, sc);
        const bf16* kg = MQK + 512 + h * 128 + ((size_t)b * SEQ + sr) * 1024 + sc; const bf16* vg = PROJ + C_MV + h * 256 + ((size_t)b * SEQ + sr) * NPROJ + sc;
        const int vbh = (int)(unsigned)(size_t)(L + vh * 16384) + v_rd_base(lane);
        int ka[2];
#pragma unroll
        for (int u = 0; u < 2; ++u) { const int q = lane & 15, G = lane >> 4, row = 8 * (G >> 1) + 4 * u + (q >> 2), colB = 2 * (32 * ti + 16 * (G & 1) + 4 * (q & 3));
            ka[u] = (int)(unsigned)(size_t)(L + K_OFF) + KSWZ(row, colB); }
        const bf16x8 ones = (bf16x8){0x3F80, 0x3F80, 0x3F80, 0x3F80, 0x3F80, 0x3F80, 0x3F80, 0x3F80};
        SJ_LOAD(128 * c);
        VM_WAIT(); SJ_WRITE(0);
        SJ_LOAD(128 * c + 64);
        __syncthreads();
#pragma unroll
        for (int half = 0; half < 2; ++half) {
            const float bm = BMX[2 * c + half];
            const float Rn = fmaxf(R, bm);
            if (Rn != R) { const float a_ = __builtin_amdgcn_exp2f(R - Rn);
#pragma unroll
                for (int r = 0; r < 16; ++r) { t0[r] *= a_; t1[r] *= a_; t2[r] *= a_; t3[r] *= a_; zz[r] *= a_; } }
            R = Rn;
            if (half == 0) { SJ_TILE(0, __builtin_amdgcn_exp2f(bm - Rn)); VM_WAIT(); SJ_WRITE(1); __syncthreads(); }
            else { SJ_TILE(1, __builtin_amdgcn_exp2f(bm - Rn)); }
        }
        { bf16* img = (bf16*)(p.ws + WS_MST_IMG) + (size_t)(h * 16 + c + 1) * 128 * 256;
#pragma unroll
          for (int r = 0; r < 16; ++r) { const int d = 32 * ti + crow(r, hi); GAS unsigned short* row = (GAS unsigned short*)img + (size_t)d * 256 + 128 * vh + r32;
              row[0] = (unsigned short)f2bf(t0[r]); row[32] = (unsigned short)f2bf(t1[r]); row[64] = (unsigned short)f2bf(t2[r]); row[96] = (unsigned short)f2bf(t3[r]); }
          if (vh == 0 && r32 == 0) { GAS float* zb = (GAS float*)(p.ws + WS_MST_Z) + (h * 16 + c + 1) * 128 + 32 * ti;
#pragma unroll
              for (int r = 0; r < 16; ++r) zb[crow(r, hi)] = zz[r]; }
          if (tid == 0) ((GAS float*)(p.ws + WS_MST_R))[h * 16 + c + 1] = R; }
        asm volatile("s_waitcnt vmcnt(0)" ::: "memory");
        __syncthreads();
        if (tid == 0) { __builtin_amdgcn_fence(__ATOMIC_RELEASE, "agent"); asm volatile("s_waitcnt vmcnt(0)" ::: "memory");
            __hip_atomic_store(ctr, (unsigned)(c + 1), __ATOMIC_RELAXED, __HIP_MEMORY_SCOPE_AGENT); }
    }
#undef SJ_TRRD
#undef SJ_LOAD
#undef SJ_WRITE
#undef SJ_VF
#undef SJ_TILE
}
#undef KSWZ
#undef MX_PK4
}

__device__ __forceinline__ void phase_mix_mfma(const Frame& F0, KArgs a, int layer, int it) { Frame F = relocal(F0);
    constexpr int NSJ = GB * 4, NCH = GB * 8, NMB = GB * 64, NML = GB * 64, NTASK = NSJ + NCH + NMB + NML;
    static_assert(GB == 1, "task decode");
    unsigned* ctr0 = (unsigned*)(F.ctl + CW_Q2 + 64 * (it + NIT * F.team)) + 1;
    volatile LAS unsigned* slot = F.MISC + 16;
    mx::MixArgs ma; ma.ws = F.ws; ma.rel_bias = a->in[14]; ma.norm_w = a->in[5] + (size_t)layer * 1024;
    LAS unsigned char* L = F.lds + RING_OFF;
    for (;;) {
        __syncthreads();
        if (F.tid == 0) slot[0] = __hip_atomic_fetch_add((unsigned*)(F.ctl + CW_Q2 + 64 * (it + NIT * F.team)), 1u, RLX_AGENT);
        __syncthreads();
        const int task = (int)slot[0];
        if (task >= NTASK) break;
        if (task < NSJ) { mx::mlstm_state_job(ma, L, 0, task, ctr0 + task); continue; }
        if (task < NSJ + NCH) { mx::mix_ret_chain(ma, L, 0, task - NSJ); continue; }
        if (task < NSJ + NCH + NMB) { const int r = task - NSJ - NCH; mx::mix_block<2>(ma, L, 0, r & 7, 7 - (r >> 3)); continue; }
        { const int r = task - NSJ - NCH - NMB; mx::mix_block<1, true>(ma, L, 0, r & 3, r >> 2, ctr0 + (r & 3)); }
    }
    __syncthreads();
}

__global__ void __launch_bounds__(NWAVES * 64, 2) hybrid_fwd(Args args) {
    extern __shared__ __attribute__((aligned(16))) unsigned char lds[];
    Frame F;
    F.lds = (LAS unsigned char*)lds;
    F.MISC = (volatile LAS unsigned*)(F.lds + MISC_OFF);
    F.tid = threadIdx.x; F.lane = F.tid & 63; F.wave = __builtin_amdgcn_readfirstlane(F.tid >> 6);
    const int bx = blockIdx.x, gall = gridDim.x;
    F.team = (bx & 7) / XPT; F.bidx = (bx >> 3) * XPT + (bx & 7) % XPT; F.G = gall / NTEAM;
    F.vcu = ((bx & 7) % XPT) * (F.G / XPT) + (bx >> 3);
    F.wsw = args.ws; F.ws = args.ws + WS_ACT + (size_t)F.team * TEAM_STRIDE; F.out = args.out;
    F.ctl = (gu32*)(args.ws + WS_CTL);
    for (int u = F.tid; u < (LDS_BYTES - LDSCTL_OFF) / 4; u += NWAVES * 64) ((LAS unsigned*)(F.lds + LDSCTL_OFF))[u] = 0u;
    __syncthreads();
    XcdBarrier barG = xcd_barrier_post((unsigned*)(F.ctl + CW_BAR), F.MISC + 8, (unsigned)gall);
    XcdBarrier bar = xcd_barrier_post((unsigned*)(F.ctl + CW_BAR) + (1 + F.team) * XCD_BAR_WORDS, F.MISC + 10, (unsigned)F.G);
    static_assert((CW_BAR + (1 + NTEAM) * XCD_BAR_WORDS) * 4 <= (int)CTL_ZERO_BYTES && CW_Q2 + 64 * NIT * NTEAM <= CW_BAR, "control words");
#define SEAM() xcd_barrier(bar)

    phase_prologue(F, kargs(), 0, PRO_PER_L, bx, gall, true);
    xcd_barrier(barG);
    { const int t = F.team;
        const int i0 = PRO_PER_L + (int)((long)PRO_PER_L * t / NTEAM), i1 = PRO_PER_L + (int)((long)PRO_PER_L * (t + 1) / NTEAM);
        phase_prologue(F, kargs(), i0, i1, F.bidx, F.G, false); SEAM();
        if (F.bidx == 0 && F.tid == 0) __hip_atomic_fetch_add((unsigned*)(F.ctl + CW_FLAG), 1u, RLX_AGENT); }

#pragma unroll 1
    for (int it = 0; it < NIT; ++it) {
        const int layer = it / GPT, grp = F.team * GPT + it % GPT;
        if (it == GPT) {
            if (F.tid == 0) { unsigned sp = 0; while (__hip_atomic_load((unsigned*)(F.ctl + CW_FLAG), RLX_AGENT) < (unsigned)NTEAM) { __builtin_amdgcn_s_sleep(8); if (++sp > (1u << 22)) break; }
                __builtin_amdgcn_fence(__ATOMIC_ACQUIRE, "agent"); asm volatile("s_waitcnt vmcnt(0)" ::: "memory"); }
            __syncthreads();
        }
        const size_t grow0 = (size_t)grp * MG;
        const float* xin = (layer == 0 ? kargs()->in[0] : (const float*)F.out) + grow0 * DM;
        float* xout = F.out + grow0 * DM;
        bf16* HB = (bf16*)(opq(F.ws) + WS_HB); bf16* PROJ = (bf16*)(opq(F.ws) + WS_PROJ); bf16* MIXED = (bf16*)(opq(F.ws) + WS_MIXED); bf16* UB = (bf16*)(opq(F.ws) + WS_PROJ);

        if (layer == 0) phase_norm1<false>(F, kargs(), layer, xin); else phase_norm1<true>(F, kargs(), layer, xin);
        SEAM();

        {
            { pg8::Gemm g{(const bf16*)(opq(F.ws) + WS_HB8), (const bf16*)(opq(F.wsw) + WS_WIN8 + layer * SZ_WIN8), DM / 2, 0, 0}; pg8::StaticOrder S; S.init(MG, NP8, F.G, F.bidx);
              pg8::EpiProj<false> E{PROJ, NPROJ, NP16 / 256};
              pg8::gemm_phase<pg8::EpiProj<false>, pg8::StaticOrder, true, true, true>(F.lds + RING_OFF, g, S, E); }
            { pg8::Gemm g{HB, (const bf16*)(opq(F.wsw) + WS_WIN + layer * SZ_WIN), DM, 0, 0}; pg8::StaticOrder S; S.init(MG, NP16, F.G, F.bidx);
              pg8::EpiProj<true> E{PROJ, NPROJ, 0};
              pg8::gemm_phase<pg8::EpiProj<true>, pg8::StaticOrder, true, true, false>(F.lds + RING_OFF, g, S, E); }
            for (int bh = F.bidx; bh < GB * 4; bh += F.G) gate_scan(F, bh);
            SEAM();
        }

        phase_prep(F, kargs(), layer); SEAM();

        phase_mix_mfma(F, kargs(), layer, it); SEAM();

        {
            pg8::Gemm g{(const bf16*)(opq(F.ws) + WS_Y), (const bf16*)(opq(F.wsw) + WS_WBR + layer * SZ_WBR), 1024, (size_t)MG * 1024 * 2, (size_t)DM * 1024 * 2};
            { pg8::Gemm g8{(const bf16*)(opq(F.ws) + WS_Y + (size_t)2 * MG * 1024 * 2), (const bf16*)(opq(F.wsw) + WS_WBR8 + layer * SZ_WBR8), 512, 0, 0};
              pg8::StaticOrder S; S.init(MG, DM, F.G, F.bidx);
              pg8::EpiBranch E{MIXED, DM, PROJ + C_GATE, NPROJ, DM, 2};
              pg8::gemm_phase<pg8::EpiBranch, pg8::StaticOrder, true, true, true>(F.lds + RING_OFF, g8, S, E); }
            { pg8::PairOrder S; S.init(MG, DM, F.G, F.bidx);
              pg8::EpiBranch E{MIXED, DM, PROJ + C_GATE, NPROJ, DM, -1};
              pg8::gemm_phase<pg8::EpiBranch, pg8::PairOrder, true, true>(F.lds + RING_OFF, g, S, E); }
            SEAM();
        }

        {
            pg8::Gemm g{MIXED, (const bf16*)(opq(F.wsw) + WS_WOUT + layer * SZ_WOUT), DM, 0, 0}; pg8::StaticOrder S; S.init(MG, DM, F.G, F.bidx);
            bf16* HRAW = (bf16*)(opq(F.ws) + WS_HRAW); float* SSP = (float*)(opq(F.ws) + WS_SSP); const float* gain2 = kargs()->in[11] + (size_t)layer * DM;
            if (layer == 0) { pg8::EpiResB<true, true> E{xin, (bf16*)xout, DM, 2 * DM, HRAW, gain2, SSP, DM}; pg8::gemm_phase<pg8::EpiResB<true, true>, pg8::StaticOrder, true, true>(F.lds + RING_OFF, g, S, E); }
            else { pg8::EpiResB<false, true> E{xout, (bf16*)xout, 2 * DM, 2 * DM, HRAW, gain2, SSP, DM}; pg8::gemm_phase<pg8::EpiResB<false, true>, pg8::StaticOrder, true, true>(F.lds + RING_OFF, g, S, E); }
            SEAM();
        }

        {
            { Frame Fl = relocal(F); LAS float* rt = (LAS float*)(Fl.lds + RSTD_OFF); const float* ssp = (const float*)(opq(Fl.ws) + WS_SSP);
              for (int r = Fl.tid; r < MG; r += NWAVES * 64) { const GAS f32x4* p = (const GAS f32x4*)(ssp + (size_t)r * 32); f32x4 s4 = p[0];
#pragma unroll
                  for (int j = 1; j < 8; ++j) s4 += p[j];
                  rt[r] = 1.0f / sqrtf(((s4.x + s4.y) + (s4.z + s4.w)) * (1.f / DM) + EPS); }
              __syncthreads(); }
            pg8::Gemm g{(const bf16*)xout, (const bf16*)(opq(F.wsw) + WS_WFF1 + layer * SZ_WFF), DM, 0, 0, 2 * DM};     pg8::RevOrder S; S.init(MG, DFF, F.G, F.bidx);
            pg8::EpiRelu2 E{UB, DFF, (const LAS float*)(F.lds + RSTD_OFF)};
            pg8::gemm_phase<pg8::EpiRelu2, pg8::RevOrder, true, true>(F.lds + RING_OFF, g, S, E);
            SEAM();
        }

        {
            pg8::Gemm g{UB, (const bf16*)(opq(F.wsw) + WS_WFF2 + layer * SZ_WFF), DFF, 0, 0}; pg8::StaticOrder S; S.init(MG, DM, F.G, F.bidx);
            pg8::EpiResB<false> E{xout, (bf16*)xout, 2 * DM, 2 * DM, nullptr, nullptr, nullptr, 0};
            pg8::gemm_phase<pg8::EpiResB<false>, pg8::StaticOrder, true, true>(F.lds + RING_OFF, g, S, E);
            if (it == NIT - 1) SEAM();
        }
    }

    phase_final(F, kargs());
#undef SEAM
}

extern "C" void kernel_launch(void* const* d_in, const int* in_sizes, int n_in, void* d_out, int out_size, void* d_ws, size_t ws_size, hipStream_t stream) {
    static int grid = 0;
    if (grid == 0) {
        if (n_in != 16 || in_sizes[0] != BATCH * SEQ * DM || out_size != BATCH * SEQ * DM || ws_size < WS_END) {
            fprintf(stderr, "kernel_launch: shape/workspace mismatch (n_in %d, in0 %d, out %d, ws %zu, need %zu)\n", n_in, n_in > 0 ? in_sizes[0] : -1, out_size, ws_size, (size_t)WS_END); grid = -1; return; }
        int dev = 0, cus = 0, per_cu = 0;
        if (hipGetDevice(&dev) != hipSuccess || hipDeviceGetAttribute(&cus, hipDeviceAttributeMultiprocessorCount, dev) != hipSuccess) { grid = -1; return; }
        if (hipFuncSetAttribute((const void*)hybrid_fwd, hipFuncAttributeMaxDynamicSharedMemorySize, LDS_BYTES) != hipSuccess) { fprintf(stderr, "kernel_launch: hipFuncSetAttribute failed\n"); grid = -1; return; }
        if (hipOccupancyMaxActiveBlocksPerMultiprocessor(&per_cu, (const void*)hybrid_fwd, NWAVES * 64, LDS_BYTES) != hipSuccess || per_cu < 1)
            fprintf(stderr, "kernel_launch: note: occupancy query reports %d workgroups per CU\n", per_cu);
        (void)hipGetLastError();
        grid = cus;
        if (grid % (8 * NTEAM) != 0 && grid % 16 != 0) { fprintf(stderr, "kernel_launch: %d CUs: the two-team split needs a multiple of 16\n", grid); grid = -1; return; }
    }
    if (grid < 0) return;
    if (hipMemsetAsync((char*)d_ws + WS_CTL, 0, CTL_ZERO_BYTES, stream) != hipSuccess) return;
    Args a{};
    for (int i = 0; i < 16; ++i) a.in[i] = (const float*)d_in[i];
    a.out = (float*)d_out; a.ws = (unsigned char*)d_ws;
    hipLaunchKernelGGL(hybrid_fwd, dim3(grid), dim3(NWAVES * 64), LDS_BYTES, stream, a);
}
```
